# Optimizing an MI355X kernel written in HIP

```python
import math
import jax, jax.numpy as jnp
from jax import lax
import numpy as np

D_MODEL = 2048
BATCH = 2
SEQ = 4096
DEPTH = 1

MIX_WIDTH = D_MODEL
HGRN_WIDTH = MIX_WIDTH // 2
HGRN_HEAD_DIM = 128
HGRN_HEADS = HGRN_WIDTH // HGRN_HEAD_DIM
MLSTM_WIDTH = MIX_WIDTH - HGRN_WIDTH
MLSTM_HEADS = 4
MLSTM_HEAD_DIM = MLSTM_WIDTH // MLSTM_HEADS
CHUNK = 64
CONV_WIDTH = 5
D_FF = 256 * ((8 * D_MODEL // 3 + 255) // 256)
DN_ALPHA = (2.0 * DEPTH) ** 0.25
DN_BETA = (8.0 * DEPTH) ** -0.25
LN_EPS = 1e-5
NORM_EPS = 1e-6
M_INIT = -1e30
IN_SPLITS = (HGRN_WIDTH, HGRN_WIDTH, HGRN_WIDTH, HGRN_WIDTH, HGRN_WIDTH,
             MLSTM_WIDTH, MLSTM_WIDTH, MLSTM_WIDTH, MLSTM_WIDTH,
             MLSTM_HEADS, MLSTM_HEADS, MLSTM_HEADS, MLSTM_HEADS)
IN_COLS = 5 * HGRN_WIDTH + 4 * MLSTM_WIDTH + 4 * MLSTM_HEADS

kernel_name = 'bidir_hgrn2_mlstm_macaron_deepnorm'


def _layer_norm(x, g, b):
    xf = x.astype(jnp.float32)
    mu = jnp.mean(xf, axis=-1, keepdims=True)
    var = jnp.mean(jnp.square(xf - mu), axis=-1, keepdims=True)
    y = (xf - mu) * lax.rsqrt(var + LN_EPS)
    return (y * g.astype(jnp.float32) + b.astype(jnp.float32)).astype(x.dtype)


def _swiglu(x, w1, w3, w2):
    return (jax.nn.silu(x @ w1) * (x @ w3)) @ w2


def _to_heads(t, n):
    b_, t_, w = t.shape
    return t.reshape(b_, t_, n, w // n).transpose(0, 2, 1, 3)


def _merge_heads(t):
    b_, h_, t_, d = t.shape
    return t.transpose(0, 2, 1, 3).reshape(b_, t_, h_ * d)


def _chunk(t):
    b_, h_, t_ = t.shape[:3]
    return jnp.moveaxis(t.reshape(b_, h_, t_ // CHUNK, CHUNK, *t.shape[3:]), 2, 0)


def _unchunk(t):
    t = jnp.moveaxis(t, 0, 2)
    return t.reshape(t.shape[0], t.shape[1], t.shape[2] * t.shape[3], *t.shape[4:])


def _flip(t):
    return jnp.flip(t, axis=2)


def _hgrn2_scan(q, k, v, logf):
    b_, h_, _, dk = q.shape
    dv = v.shape[-1]
    mask = jnp.tril(jnp.ones((CHUNK, CHUNK), dtype=bool))

    def step(state, inp):
        qc, kc, vc, gc = inp
        bcum = jnp.cumsum(gc, axis=-2)
        o_inter = jnp.einsum('bhtd,bhde->bhte', qc * jnp.exp(bcum), state)
        rel = bcum[..., :, None, :] - bcum[..., None, :, :]
        decay = jnp.exp(jnp.where(mask[:, :, None], rel, -jnp.inf))
        attn = jnp.einsum('bhtd,bhsd,bhtsd->bhts', qc, kc, decay)
        o = o_inter + jnp.einsum('bhts,bhse->bhte', attn, vc)
        b_last = bcum[..., -1:, :]
        state = (jnp.exp(b_last[..., 0, :])[..., None] * state
                 + jnp.einsum('bhsd,bhse->bhde', kc * jnp.exp(b_last - bcum), vc))
        return state, o

    s0 = jnp.zeros((b_, h_, dk, dv), jnp.float32)
    _, o = lax.scan(step, s0, (_chunk(q), _chunk(k), _chunk(v), _chunk(logf)))
    return _unchunk(o)


def _mlstm_scan(q, k, v, ig, lf):
    b_, h_, _, dk = q.shape
    dv = v.shape[-1]
    mask = jnp.tril(jnp.ones((CHUNK, CHUNK), dtype=bool))

    def step(carry, inp):
        c_st, n_st, m_st = carry
        qc, kc, vc, igc, lfc = inp
        bcum = jnp.cumsum(lfc, axis=-1)
        dmat = jnp.where(mask, bcum[..., :, None] - bcum[..., None, :] + igc[..., None, :], -jnp.inf)
        m_inter = bcum + m_st[..., None]
        m_t = jnp.maximum(m_inter, jnp.max(dmat, axis=-1))
        inter_scale = jnp.exp(m_inter - m_t)
        sc = jnp.einsum('bhtd,bhsd->bhts', qc, kc) * jnp.exp(dmat - m_t[..., None])
        num = jnp.einsum('bhts,bhse->bhte', sc, vc) + inter_scale[..., None] * jnp.einsum('bhtd,bhde->bhte', qc, c_st)
        den = jnp.sum(sc, axis=-1) + inter_scale * jnp.einsum('bhtd,bhd->bht', qc, n_st)
        h = num / jnp.maximum(jnp.abs(den), jnp.exp(-m_t))[..., None]
        b_last = bcum[..., -1]
        w = b_last[..., None] - bcum + igc
        m_new = jnp.maximum(b_last + m_st, jnp.max(w, axis=-1))
        carry_scale = jnp.exp(b_last + m_st - m_new)
        kw = kc * jnp.exp(w - m_new[..., None])[..., None]
        c_new = carry_scale[..., None, None] * c_st + jnp.einsum('bhsd,bhse->bhde', kw, vc)
        n_new = carry_scale[..., None] * n_st + jnp.sum(kw, axis=-2)
        return (c_new, n_new, m_new), h

    carry0 = (jnp.zeros((b_, h_, dk, dv), jnp.float32),
              jnp.zeros((b_, h_, dk), jnp.float32),
              jnp.full((b_, h_), M_INIT, jnp.float32))
    _, h = lax.scan(step, carry0, (_chunk(q), _chunk(k), _chunk(v), _chunk(ig), _chunk(lf)))
    return _unchunk(h)


def _centred_dwconv(t, w, b):
    y = lax.conv_general_dilated(t, w[:, None, :], window_strides=(1,),
                                 padding=[(CONV_WIDTH // 2, CONV_WIDTH // 2)],
                                 dimension_numbers=('NWC', 'WIO', 'NWC'),
                                 feature_group_count=t.shape[-1])
    return y + b


def _mixer(x, layer, w_in, hgrn_lb, hgrn_norm_g, conv_w, conv_b, ig_b, fg_b, mlstm_norm_g, w_out):
    f32 = jnp.float32
    z = x @ w_in
    offsets = [int(o) for o in np.cumsum(IN_SPLITS)[:-1]]
    (hq, hi, hg, hf_fw, hf_bw, mq, mk, mv, mo, mi_fw, mi_bw, mf_fw, mf_bw) = jnp.split(z, offsets, axis=-1)

    lb = jnp.cumsum(jax.nn.softmax(hgrn_lb.astype(f32), axis=1), axis=1)[:, layer]
    q_h = _to_heads(jax.nn.silu(hq.astype(f32)) * (HGRN_HEAD_DIM ** -0.5), HGRN_HEADS)
    v_h = _to_heads(hi.astype(f32), HGRN_HEADS)

    def _forget(zf, lbd):
        f = lbd + (1.0 - lbd) * jax.nn.sigmoid(zf.astype(f32))
        return _to_heads(jnp.log(f), HGRN_HEADS), _to_heads(1.0 - f, HGRN_HEADS)

    logf_fw, k_fw = _forget(hf_fw, lb[0])
    logf_bw, k_bw = _forget(hf_bw, lb[1])
    o_h = (_hgrn2_scan(q_h, k_fw, v_h, logf_fw)
           + _flip(_hgrn2_scan(_flip(q_h), _flip(k_bw), _flip(v_h), _flip(logf_bw))))
    o_h = o_h * lax.rsqrt(jnp.mean(jnp.square(o_h), axis=-1, keepdims=True) + NORM_EPS)
    y_h = _merge_heads(o_h) * hgrn_norm_g.astype(f32) * jax.nn.silu(hg.astype(f32))

    qk = jax.nn.silu(_centred_dwconv(jnp.concatenate([mq, mk], axis=-1), conv_w, conv_b))
    mq_c, mk_c = jnp.split(qk, 2, axis=-1)
    q_m = _to_heads(mq_c.astype(f32), MLSTM_HEADS) * (MLSTM_HEAD_DIM ** -0.5)
    k_m = _to_heads(mk_c.astype(f32), MLSTM_HEADS)
    v_m = _to_heads(mv.astype(f32), MLSTM_HEADS)
    ig_fw = (mi_fw.astype(f32) + ig_b[0].astype(f32)).transpose(0, 2, 1)
    ig_bw = (mi_bw.astype(f32) + ig_b[1].astype(f32)).transpose(0, 2, 1)
    lf_fw = jax.nn.log_sigmoid(mf_fw.astype(f32) + fg_b[0].astype(f32)).transpose(0, 2, 1)
    lf_bw = jax.nn.log_sigmoid(mf_bw.astype(f32) + fg_b[1].astype(f32)).transpose(0, 2, 1)
    h_m = (_mlstm_scan(q_m, k_m, v_m, ig_fw, lf_fw)
           + _flip(_mlstm_scan(_flip(q_m), _flip(k_m), _flip(v_m), _flip(ig_bw), _flip(lf_bw))))
    mu = jnp.mean(h_m, axis=-1, keepdims=True)
    var = jnp.mean(jnp.square(h_m - mu), axis=-1, keepdims=True)
    h_m = (h_m - mu) * lax.rsqrt(var + NORM_EPS)
    y_m = _merge_heads(h_m) * mlstm_norm_g.astype(f32) * jax.nn.sigmoid(mo.astype(f32))

    y = jnp.concatenate([y_h, y_m], axis=-1).astype(x.dtype)
    return y @ w_out


def setup_inputs(seed: int = 0) -> dict:
    key = jax.random.key(seed)
    ks = jax.random.split(key, 24)
    f32 = jnp.float32
    d_sc = D_MODEL ** -0.5
    ff_sc = D_FF ** -0.5

    def nrm(k, shape, scale):
        return jax.random.normal(k, shape, f32) * scale

    col_scale = jnp.concatenate([
        jnp.ones((HGRN_WIDTH,), f32),
        jnp.full((HGRN_WIDTH,), DN_BETA, f32),
        jnp.ones((3 * HGRN_WIDTH,), f32),
        jnp.ones((2 * MLSTM_WIDTH,), f32),
        jnp.full((MLSTM_WIDTH,), DN_BETA, f32),
        jnp.ones((MLSTM_WIDTH,), f32),
        jnp.full((4 * MLSTM_HEADS,), 0.1, f32),
    ])
    fg_bias = jnp.broadcast_to(jnp.linspace(3.0, 6.0, MLSTM_HEADS, dtype=f32), (DEPTH, 2, MLSTM_HEADS))
    return {
        'x': jax.random.normal(ks[0], (BATCH, SEQ, D_MODEL), f32),
        'ffn1_w1': nrm(ks[1], (DEPTH, D_MODEL, D_FF), d_sc),
        'ffn1_w3': nrm(ks[2], (DEPTH, D_MODEL, D_FF), d_sc),
        'ffn1_w2': nrm(ks[3], (DEPTH, D_FF, D_MODEL), ff_sc * DN_BETA),
        'ln1_g': 1.0 + nrm(ks[4], (DEPTH, D_MODEL), 0.02),
        'ln1_b': nrm(ks[5], (DEPTH, D_MODEL), 0.02),
        'w_in': nrm(ks[6], (DEPTH, D_MODEL, IN_COLS), d_sc) * col_scale,
        'hgrn_lb': nrm(ks[7], (2, DEPTH + 1, HGRN_WIDTH), 0.1),
        'hgrn_norm_g': 1.0 + nrm(ks[8], (DEPTH, HGRN_WIDTH), 0.02),
        'mlstm_conv_w': nrm(ks[9], (DEPTH, CONV_WIDTH, 2 * MLSTM_WIDTH), CONV_WIDTH ** -0.5),
        'mlstm_conv_b': nrm(ks[10], (DEPTH, 2 * MLSTM_WIDTH), 0.02),
        'mlstm_ig_b': nrm(ks[11], (DEPTH, 2, MLSTM_HEADS), 0.1),
        'mlstm_fg_b': fg_bias + nrm(ks[12], (DEPTH, 2, MLSTM_HEADS), 0.1),
        'mlstm_norm_g': 1.0 + nrm(ks[13], (DEPTH, MLSTM_WIDTH), 0.02),
        'w_out': nrm(ks[14], (DEPTH, MIX_WIDTH, D_MODEL), (MIX_WIDTH ** -0.5) * DN_BETA),
        'ln2_g': 1.0 + nrm(ks[15], (DEPTH, D_MODEL), 0.02),
        'ln2_b': nrm(ks[16], (DEPTH, D_MODEL), 0.02),
        'ffn2_w1': nrm(ks[17], (DEPTH, D_MODEL, D_FF), d_sc),
        'ffn2_w3': nrm(ks[18], (DEPTH, D_MODEL, D_FF), d_sc),
        'ffn2_w2': nrm(ks[19], (DEPTH, D_FF, D_MODEL), ff_sc * DN_BETA),
        'ln3_g': 1.0 + nrm(ks[20], (DEPTH, D_MODEL), 0.02),
        'ln3_b': nrm(ks[21], (DEPTH, D_MODEL), 0.02),
    }


def reference(x, ffn1_w1, ffn1_w3, ffn1_w2, ln1_g, ln1_b, w_in, hgrn_lb, hgrn_norm_g,
              mlstm_conv_w, mlstm_conv_b, mlstm_ig_b, mlstm_fg_b, mlstm_norm_g, w_out,
              ln2_g, ln2_b, ffn2_w1, ffn2_w3, ffn2_w2, ln3_g, ln3_b):
    for l in range(DEPTH):
        x = _layer_norm(x * DN_ALPHA + 0.5 * _swiglu(x, ffn1_w1[l], ffn1_w3[l], ffn1_w2[l]), ln1_g[l], ln1_b[l])
        y = _mixer(x, l, w_in[l], hgrn_lb, hgrn_norm_g[l], mlstm_conv_w[l], mlstm_conv_b[l],
                   mlstm_ig_b[l], mlstm_fg_b[l], mlstm_norm_g[l], w_out[l])
        x = _layer_norm(x * DN_ALPHA + y, ln2_g[l], ln2_b[l])
        x = _layer_norm(x * DN_ALPHA + 0.5 * _swiglu(x, ffn2_w1[l], ffn2_w3[l], ffn2_w2[l]), ln3_g[l], ln3_b[l])
    return x
```

```cpp
#include <hip/hip_runtime.h>
#include <hip/hip_cooperative_groups.h>
#include <cstdio>
#include <cstdint>
namespace cg = cooperative_groups;
namespace pg8 {
#define PG8_LAS __attribute__((address_space(3)))
typedef unsigned short bf16_t;
typedef short bf16x8 __attribute__((ext_vector_type(8)));
typedef float f32x4 __attribute__((ext_vector_type(4)));
typedef unsigned u32x4 __attribute__((ext_vector_type(4)));
constexpr int BM = 256, BK = 64, HALF = 128, HTB = HALF * BK * 2  , STAGE_BYTES = 8 * HTB, NXCD = 8, WGM = 8;

__host__ __device__ __forceinline__ int lds_byte(int r, int c) { const int st = (r >> 4) * 2 + (c >> 5), rr = r & 15, cc = c & 31, ob = rr * 64 + cc * 2; return st * 1024 + (ob ^ (((ob >> 9) & 1) << 5)); }
__host__ __device__ __forceinline__ void stage_rc(int b, int& R, int& C) { const int st = b / 1024, sb = b % 1024, swz = sb ^ (((sb >> 9) & 1) << 5); R = (st >> 1) * 16 + swz / 64; C = (st & 1) * 32 + (swz % 64) / 2; }
__host__ __device__ __forceinline__ int perm32(int rho) { const int n = rho >> 4, i = rho & 15; return 8 * (i >> 2) + 4 * n + (i & 3); }

struct Unit { int pm, pn; };
struct Gemm { const bf16_t* A; const bf16_t* Bt; int M, N, K; };

struct StaticOrder {
    int nM, nN, nwg, G, c;
    __host__ __device__ void init(int M, int N, int G_, int c_) { nM = M / BM; nN = N / BM; nwg = nM * nN; G = G_; c = c_; }
    __host__ __device__ bool next(int i, Unit& u) const {
        const long L = (long)i * G + c; if (L >= nwg) return false;
        int wgid = (int)L; { const int q = nwg / NXCD, r = nwg % NXCD, xcd = wgid % NXCD, off = wgid / NXCD; wgid = (xcd < r ? xcd * (q + 1) : r * (q + 1) + (xcd - r) * q) + off; }
        const int nig = WGM * nN, gid = wgid / nig, fm = gid * WGM, gsz = (nM - fm) < WGM ? (nM - fm) : WGM;
        u.pm = fm + ((wgid % nig) % gsz); u.pn = (wgid % nig) / gsz; return true;
    }
    __device__ __forceinline__ void a_ready(const Unit&) const {}
    __device__ __forceinline__ void done(const Unit&) const {}
};

__device__ __forceinline__ unsigned cvt_pk_bf16(float lo, float hi) { unsigned r; asm volatile("v_cvt_pk_bf16_f32 %0, %1, %2" : "=v"(r) : "v"(lo), "v"(hi)); return r; }
typedef float f32x2 __attribute__((ext_vector_type(2)));
template <class Epi, class Sched, bool ALIGN_EPI = false, bool SP2 = false>
__device__ __forceinline__ void gemm_phase(PG8_LAS unsigned char* lds, const Gemm g, const Sched& S, const Epi& E) {
    const int tid = threadIdx.x, wid = __builtin_amdgcn_readfirstlane(tid >> 6), lane = tid & 63, wr = wid >> 2, wc = wid & 3, fr = lane & 15, fq = lane >> 4;
    const int K = g.K, nt = K / BK;
    unsigned voffA[2], voffB[2];
#pragma unroll
    for (int i = 0; i < 2; ++i) { int R, C; stage_rc(tid * 16 + i * 8192, R, C); const int Rb = Epi::PERM ? ((R & ~31) + perm32(R & 31)) : R;
        voffA[i] = (unsigned)(R * K + C) * 2u; voffB[i] = (unsigned)(Rb * K + C) * 2u; }
    const size_t kstep = (size_t)(BK * 2);
    const size_t hstep = (size_t)HALF * K * 2;
    const size_t tstep = 2 * hstep;
    const unsigned ldsw = (unsigned)wid * 1024u;
    const int aoff = lds_byte(wr * 64 + fr, fq * 8), boff = lds_byte(wc * 32 + fr, fq * 8);
#define PG8_SA(b, h) (((b) * 2 + (h)) * HTB)
#define PG8_SB(b, h) ((4 + (b) * 2 + (h)) * HTB)
#define PG8_STAGE(bufoff, gbase, voff) do { _Pragma("unroll") for (int _i = 0; _i < 2; ++_i) \
        __builtin_amdgcn_global_load_lds((const unsigned*)((const char*)(gbase) + (voff)[_i]), (PG8_LAS unsigned*)(lds + (bufoff) + ldsw + _i * 8192), 16, 0, 0); } while (0)
#define PG8_LDA(dst, b, h) do { _Pragma("unroll") for (int m = 0; m < 4; ++m) _Pragma("unroll") for (int k = 0; k < 2; ++k) dst[m][k] = *(const PG8_LAS bf16x8*)(lds + PG8_SA(b, h) + aoff + m * 2048 + k * 1024); } while (0)
#define PG8_LDB(dst, b, h) do { _Pragma("unroll") for (int n = 0; n < 2; ++n) _Pragma("unroll") for (int k = 0; k < 2; ++k) dst[n][k] = *(const PG8_LAS bf16x8*)(lds + PG8_SB(b, h) + boff + n * 2048 + k * 1024); } while (0)
#define PG8_MMA(ai, bj, At, Bt) do { __builtin_amdgcn_s_setprio(1); _Pragma("unroll") for (int m = 0; m < 4; ++m) _Pragma("unroll") for (int n = 0; n < 2; ++n) _Pragma("unroll") for (int k = 0; k < 2; ++k) \
        acc[ai][bj][m][n] = __builtin_amdgcn_mfma_f32_16x16x32_bf16(Bt[n][k], At[m][k], acc[ai][bj][m][n], 0, 0, 0); __builtin_amdgcn_s_setprio(0); } while (0)
#define PG8_WAIT_V(n) asm volatile("s_waitcnt vmcnt(" #n ")" ::: "memory")
#define PG8_WAIT_L(n) asm volatile("s_waitcnt lgkmcnt(" #n ")" ::: "memory")
#define PG8_BAR __builtin_amdgcn_s_barrier()
#define PG8_SCHED __builtin_amdgcn_sched_barrier(0)
    Unit cur, nxt; int ui = 0;
    if (!S.next(0, cur)) return;
    f32x4 acc[2][2][4][2];
#pragma unroll
    for (int a = 0; a < 2; ++a)
#pragma unroll
        for (int b = 0; b < 2; ++b)
#pragma unroll
            for (int m = 0; m < 4; ++m)
#pragma unroll
                for (int n = 0; n < 2; ++n) acc[a][b][m][n] = (f32x4){0.f, 0.f, 0.f, 0.f};
    bf16x8 At[4][2], B0[2][2], B1[2][2];
    const char* cA = (const char*)g.A + (size_t)cur.pm * tstep; const char* cB = (const char*)g.Bt + (size_t)cur.pn * tstep;
    S.a_ready(cur);
    if constexpr (SP2) {
        PG8_STAGE(PG8_SB(0, 0), cB, voffB); PG8_STAGE(PG8_SB(0, 1), cB + hstep, voffB); PG8_STAGE(PG8_SA(0, 0), cA, voffA); PG8_STAGE(PG8_SA(0, 1), cA + hstep, voffA);
        if (wr == 1) PG8_BAR;
        PG8_WAIT_V(2); PG8_BAR;
        PG8_STAGE(PG8_SB(1, 0), cB + kstep, voffB); PG8_STAGE(PG8_SA(1, 0), cA + kstep, voffA); PG8_STAGE(PG8_SB(1, 1), cB + hstep + kstep, voffB);
        PG8_WAIT_V(6); PG8_BAR;
    } else {
        PG8_STAGE(PG8_SB(0, 0), cB, voffB); PG8_STAGE(PG8_SA(0, 0), cA, voffA); PG8_STAGE(PG8_SB(0, 1), cB + hstep, voffB); PG8_STAGE(PG8_SA(0, 1), cA + hstep, voffA);
        if (wr == 1) PG8_BAR;
        PG8_WAIT_V(4); PG8_BAR;
        PG8_STAGE(PG8_SB(1, 0), cB + kstep, voffB); PG8_STAGE(PG8_SA(1, 0), cA + kstep, voffA); PG8_STAGE(PG8_SB(1, 1), cB + hstep + kstep, voffB);
        PG8_WAIT_V(6); PG8_BAR;
    }
    for (;;) {
        const bool has_next = S.next(ui + 1, nxt);
        const char* nA = has_next ? (const char*)g.A + (size_t)nxt.pm * tstep : cA; const char* nB = has_next ? (const char*)g.Bt + (size_t)nxt.pn * tstep : cB;
        for (int t = 0; t < nt; t += 2) {
            const bool last = (t == nt - 2);
            const char* a1 = cA + (size_t)(t + 1) * kstep;
            const char* a2 = last ? nA : cA + (size_t)(t + 2) * kstep; const char* b2 = last ? nB : cB + (size_t)(t + 2) * kstep;
            const char* a3 = a2 + kstep; const char* b3 = b2 + kstep;
            if (last && has_next) S.a_ready(nxt);
            if constexpr (SP2) {
            PG8_LDB(B0, 0, 0); PG8_LDB(B1, 0, 1); PG8_SCHED; PG8_LDA(At, 0, 0); PG8_STAGE(PG8_SA(1, 1), a1 + hstep, voffA);
            PG8_WAIT_V(8); PG8_WAIT_L(0); PG8_BAR; PG8_MMA(0, 0, At, B0); PG8_MMA(0, 1, At, B1); PG8_BAR; PG8_SCHED;
            PG8_LDA(At, 0, 1); PG8_STAGE(PG8_SB(0, 0), b2, voffB); PG8_STAGE(PG8_SB(0, 1), b2 + hstep, voffB); PG8_STAGE(PG8_SA(0, 0), a2, voffA);
            PG8_WAIT_V(8); PG8_WAIT_L(0); PG8_BAR; PG8_MMA(1, 0, At, B0); PG8_MMA(1, 1, At, B1); PG8_BAR; PG8_SCHED;
            PG8_LDB(B0, 1, 0); PG8_LDB(B1, 1, 1); PG8_SCHED; PG8_LDA(At, 1, 0); PG8_STAGE(PG8_SA(0, 1), a2 + hstep, voffA);
            PG8_WAIT_V(8); PG8_WAIT_L(0); PG8_BAR; PG8_MMA(0, 0, At, B0); PG8_MMA(0, 1, At, B1); PG8_BAR; PG8_SCHED;
            PG8_LDA(At, 1, 1); PG8_STAGE(PG8_SB(1, 0), b3, voffB); PG8_STAGE(PG8_SB(1, 1), b3 + hstep, voffB); PG8_STAGE(PG8_SA(1, 0), a3, voffA);
            PG8_WAIT_V(8); PG8_WAIT_L(0); PG8_BAR; PG8_MMA(1, 0, At, B0); PG8_MMA(1, 1, At, B1); PG8_BAR; PG8_SCHED;
            } else {
            PG8_LDB(B0, 0, 0); PG8_SCHED; PG8_LDA(At, 0, 0); PG8_STAGE(PG8_SA(1, 1), a1 + hstep, voffA);
            PG8_WAIT_L(8); PG8_BAR; PG8_WAIT_L(0); PG8_MMA(0, 0, At, B0); PG8_BAR; PG8_SCHED;
            PG8_LDB(B1, 0, 1); PG8_STAGE(PG8_SB(0, 0), b2, voffB);
            PG8_BAR; PG8_WAIT_L(0); PG8_MMA(0, 1, At, B1); PG8_BAR;
            PG8_LDA(At, 0, 1); PG8_STAGE(PG8_SA(0, 0), a2, voffA);
            PG8_BAR; PG8_WAIT_L(0); PG8_MMA(1, 0, At, B0); PG8_BAR; PG8_SCHED;
            PG8_STAGE(PG8_SB(0, 1), b2 + hstep, voffB);
            PG8_WAIT_V(6); PG8_BAR; PG8_MMA(1, 1, At, B1); PG8_BAR;
            PG8_LDB(B0, 1, 0); PG8_SCHED; PG8_LDA(At, 1, 0); PG8_STAGE(PG8_SA(0, 1), a2 + hstep, voffA);
            PG8_WAIT_L(8); PG8_BAR; PG8_WAIT_L(0); PG8_MMA(0, 0, At, B0); PG8_BAR; PG8_SCHED;
            PG8_LDB(B1, 1, 1); PG8_STAGE(PG8_SB(1, 0), b3, voffB);
            PG8_BAR; PG8_WAIT_L(0); PG8_MMA(0, 1, At, B1); PG8_BAR;
            PG8_LDA(At, 1, 1); PG8_STAGE(PG8_SA(1, 0), a3, voffA);
            PG8_BAR; PG8_WAIT_L(0); PG8_MMA(1, 0, At, B0); PG8_BAR; PG8_SCHED;
            PG8_STAGE(PG8_SB(1, 1), b3 + hstep, voffB);
            PG8_WAIT_V(6); PG8_BAR; PG8_MMA(1, 1, At, B1); PG8_BAR;
            }
        }
        if constexpr (ALIGN_EPI) { if (wr == 0) PG8_BAR; }
        if constexpr (!Epi::AFTER_DRAIN) { E(acc, cur, wr, wc, fr, fq); S.done(cur); }
        if (!has_next) break;
#pragma unroll
        for (int a = 0; a < 2; ++a)
#pragma unroll
            for (int b = 0; b < 2; ++b)
#pragma unroll
                for (int m = 0; m < 4; ++m)
#pragma unroll
                    for (int n = 0; n < 2; ++n) acc[a][b][m][n] = (f32x4){0.f, 0.f, 0.f, 0.f};
        cur = nxt; cA = nA; cB = nB; ++ui;
        if constexpr (ALIGN_EPI) { if (wr == 1) PG8_BAR; }
    }
    PG8_WAIT_V(0);
    if constexpr (!ALIGN_EPI) { if (wr == 0) PG8_BAR; }
    PG8_BAR;
    if constexpr (Epi::AFTER_DRAIN) { E.fused(acc, cur, wr, wc, fr, fq, lds, wid, lane); S.done(cur); }
#undef PG8_SA
#undef PG8_SB
#undef PG8_STAGE
#undef PG8_LDA
#undef PG8_LDB
#undef PG8_MMA
#undef PG8_WAIT_V
#undef PG8_WAIT_L
#undef PG8_BAR
#undef PG8_SCHED
}
}
#define LAS __attribute__((address_space(3)))
typedef unsigned short bf16;
typedef float f32x4 __attribute__((ext_vector_type(4)));
typedef short bf16x8 __attribute__((ext_vector_type(8)));
typedef unsigned u32x4 __attribute__((ext_vector_type(4)));
typedef unsigned u32x2 __attribute__((ext_vector_type(2)));
constexpr int T = 4096, M = 8192, D = 2048, FF = 5632, ZC = 9216, INC = 9232;
constexpr float ALPHA = 1.189207115002721f;
constexpr size_t MiB = 1u << 20;
constexpr size_t WS_W13 = 1 * MiB, WS_W2 = 45 * MiB, WS_WIN = 67 * MiB, WS_WOUT = 103 * MiB, WS_WG = 111 * MiB, WS_G = 112 * MiB,
                 WS_XF = 113 * MiB, WS_XB = 177 * MiB, WS_ZH = 209 * MiB, WS_Y = 353 * MiB, WS_AB = 385 * MiB, WS_DEC = 401 * MiB, WS_PS = 402 * MiB, WS_X3 = 410 * MiB, WS_END = 411 * MiB;
constexpr int LDS_BYTES = 147456;

__device__ __forceinline__ float bf2f(unsigned short h) { return __uint_as_float((unsigned)h << 16); }
__device__ __forceinline__ float bflo(unsigned u) { return __uint_as_float(u << 16); }
__device__ __forceinline__ float bfhi(unsigned u) { return __uint_as_float(u & 0xffff0000u); }
typedef float f32x2_t __attribute__((ext_vector_type(2)));
typedef __bf16 bf16x2_t __attribute__((ext_vector_type(2)));
__device__ __forceinline__ unsigned pk_c(float lo, float hi) { f32x2_t v = {lo, hi}; bf16x2_t b = __builtin_convertvector(v, bf16x2_t); return __builtin_bit_cast(unsigned, b); }
__device__ __forceinline__ unsigned pk(float lo, float hi) { return pg8::cvt_pk_bf16(lo, hi); }
__device__ __forceinline__ float sigm(float x) { return __builtin_amdgcn_rcpf(1.f + __expf(-x)); }
__device__ __forceinline__ float silu(float x) { return x * sigm(x); }
__device__ __forceinline__ float wave_sum(float v) {
#pragma unroll
    for (int o = 1; o < 64; o <<= 1) v += __shfl_xor(v, o);
    return v;
}

namespace pg8 {
struct MapOrder {
    StaticOrder S; int split, off0, off1;
    __device__ void init(int M, int ncols, int G_, int c_, int split_, int off0_, int off1_) { S.init(M, ncols * BM, G_, c_); split = split_; off0 = off0_; off1 = off1_; }
    __device__ bool next(int i, Unit& u) const { if (!S.next(i, u)) return false; u.pn += (u.pn < split) ? off0 : off1; return true; }
    __device__ __forceinline__ void a_ready(const Unit&) const {}
    __device__ __forceinline__ void done(const Unit&) const {}
};
struct EpiSwiglu {
    static constexpr bool PERM = true, AFTER_DRAIN = false;
    bf16_t* H; int ldh;
    __device__ __forceinline__ void operator()(const f32x4 (&acc)[2][2][4][2], const Unit& u, int wr, int wc, int fr, int fq) const {
        const int row0 = u.pm * BM + wr * 64 + fr, col0 = u.pn * HALF + wc * 32 + 8 * fq;
#pragma unroll
        for (int ai = 0; ai < 2; ++ai)
#pragma unroll
            for (int m = 0; m < 4; ++m) {
                const f32x4 g0 = acc[ai][0][m][0], g1 = acc[ai][0][m][1], u0 = acc[ai][1][m][0], u1 = acc[ai][1][m][1];
                u32x4 w;
                w.x = cvt_pk_bf16(silu(g0[0]) * u0[0], silu(g0[1]) * u0[1]); w.y = cvt_pk_bf16(silu(g0[2]) * u0[2], silu(g0[3]) * u0[3]);
                w.z = cvt_pk_bf16(silu(g1[0]) * u1[0], silu(g1[1]) * u1[1]); w.w = cvt_pk_bf16(silu(g1[2]) * u1[2], silu(g1[3]) * u1[3]);
                *(u32x4*)(H + (size_t)(row0 + ai * HALF + m * 16) * ldh + col0) = w;
            }
    }
};
struct EpiPlain {
    static constexpr bool PERM = true, AFTER_DRAIN = false;
    bf16_t* O; int ldc;
    __device__ __forceinline__ void operator()(const f32x4 (&acc)[2][2][4][2], const Unit& u, int wr, int wc, int fr, int fq) const {
        const int row0 = u.pm * BM + wr * 64 + fr, col0 = u.pn * BM + wc * 32 + 8 * fq;
#pragma unroll
        for (int ai = 0; ai < 2; ++ai)
#pragma unroll
            for (int m = 0; m < 4; ++m)
#pragma unroll
                for (int bj = 0; bj < 2; ++bj) {
                    const f32x4 v0 = acc[ai][bj][m][0], v1 = acc[ai][bj][m][1];
                    u32x4 w; w.x = cvt_pk_bf16(v0[0], v0[1]); w.y = cvt_pk_bf16(v0[2], v0[3]); w.z = cvt_pk_bf16(v1[0], v1[1]); w.w = cvt_pk_bf16(v1[2], v1[3]);
                    *(u32x4*)(O + (size_t)(row0 + ai * HALF + m * 16) * ldc + col0 + bj * HALF) = w;
                }
    }
};
struct EpiRes {
    static constexpr bool PERM = false, AFTER_DRAIN = false;
    const float* res; float* out; int ldc; float ra, sa;
    __device__ __forceinline__ void operator()(const f32x4 (&acc)[2][2][4][2], const Unit& u, int wr, int wc, int fr, int fq) const {
        const int row0 = u.pm * BM + wr * 64 + fr, col0 = u.pn * BM + wc * 32 + 4 * fq;
#pragma unroll
        for (int ai = 0; ai < 2; ++ai)
#pragma unroll
            for (int m = 0; m < 4; ++m) {
                const size_t off = (size_t)(row0 + ai * HALF + m * 16) * ldc + col0;
#pragma unroll
                for (int bj = 0; bj < 2; ++bj)
#pragma unroll
                    for (int n = 0; n < 2; ++n) {
                        const f32x4 r = *(const f32x4*)(res + off + bj * HALF + n * 16);
                        *(f32x4*)(out + off + bj * HALF + n * 16) = r * ra + acc[ai][bj][m][n] * sa;
                    }
            }
    }
};
struct EpiResLN {
    static constexpr bool PERM = false, AFTER_DRAIN = true;
    const bf16_t* res; const float* resF; float ra, sa; const float* gam; const float* bet; float* outF; bf16_t* outB; float* xbuf; unsigned* cnt;
    __device__ __forceinline__ void fused(f32x4 (&acc)[2][2][4][2], const Unit& u, int wr, int wc, int fr, int fq, PG8_LAS unsigned char* lds, int wid, int lane) const {
        typedef float f32x2v __attribute__((ext_vector_type(2)));
        PG8_LAS f32x2v* Pst = (PG8_LAS f32x2v*)lds;
        PG8_LAS f32x2v* St = (PG8_LAS f32x2v*)(lds + 8192);
        const int row0 = u.pm * BM + wr * 64 + fr, col0 = u.pn * BM + wc * 32 + 4 * fq, ldc = 2048;
        f32x4 rr[4][4];
#define RES_LOAD(g_) do { const size_t off_ = (size_t)(row0 + ((g_) >> 2) * HALF + ((g_) & 3) * 16) * ldc + col0; \
            _Pragma("unroll") for (int bj = 0; bj < 2; ++bj) _Pragma("unroll") for (int n = 0; n < 2; ++n) { if (resF) rr[(g_) & 3][bj * 2 + n] = __builtin_nontemporal_load((const f32x4*)(resF + off_ + bj * HALF + n * 16)); \
              else { const u32x2 t_ = __builtin_nontemporal_load((const u32x2*)(res + off_ + bj * HALF + n * 16)); rr[(g_) & 3][bj * 2 + n] = (f32x4){::bflo(t_.x), ::bfhi(t_.x), ::bflo(t_.y), ::bfhi(t_.y)}; } } } while (0)
        RES_LOAD(0); RES_LOAD(1); RES_LOAD(2); RES_LOAD(3);
#pragma unroll
        for (int g = 0; g < 8; ++g) {
            const int ai = g >> 2, m = g & 3; float s = 0.f, q = 0.f;
#pragma unroll
            for (int bj = 0; bj < 2; ++bj)
#pragma unroll
                for (int n = 0; n < 2; ++n) { const f32x4 v = rr[g & 3][bj * 2 + n] * ra + acc[ai][bj][m][n] * sa; acc[ai][bj][m][n] = v;
                    s += (v[0] + v[1]) + (v[2] + v[3]); q += (v[0] * v[0] + v[1] * v[1]) + (v[2] * v[2] + v[3] * v[3]); }
            if (g + 4 < 8) RES_LOAD(g + 4);
            s += __shfl_xor(s, 16); s += __shfl_xor(s, 32); q += __shfl_xor(q, 16); q += __shfl_xor(q, 32);
            if (fq == 0) Pst[(ai * HALF + wr * 64 + m * 16 + fr) * 4 + wc] = (f32x2v){s, q};
        }
#undef RES_LOAD
        asm volatile("s_waitcnt lgkmcnt(0)" ::: "memory"); __builtin_amdgcn_s_barrier(); asm volatile("" ::: "memory");
        const int tid = wid * 64 + lane;
        if (tid < 256) { const f32x2v a = Pst[tid * 4 + 0], b = Pst[tid * 4 + 1], c = Pst[tid * 4 + 2], d = Pst[tid * 4 + 3];
            const float ps = (a.x + b.x) + (c.x + d.x), pq = (a.y + b.y) + (c.y + d.y);
            __hip_atomic_store((unsigned long long*)(xbuf + ((size_t)(u.pm * 8 + u.pn) * 256 + tid) * 2), ((unsigned long long)__float_as_uint(pq) << 32) | __float_as_uint(ps), __ATOMIC_RELAXED, __HIP_MEMORY_SCOPE_AGENT); }
        asm volatile("s_waitcnt vmcnt(0) lgkmcnt(0)" ::: "memory"); __builtin_amdgcn_s_barrier(); asm volatile("" ::: "memory");
        if (tid == 0) {
            __hip_atomic_fetch_add(cnt + 64 * u.pm, 1u, __ATOMIC_RELAXED, __HIP_MEMORY_SCOPE_AGENT);
            while (__hip_atomic_load(cnt + 64 * u.pm, __ATOMIC_RELAXED, __HIP_MEMORY_SCOPE_AGENT) < 8u) __builtin_amdgcn_s_sleep(1);
            __builtin_amdgcn_fence(__ATOMIC_ACQUIRE, "agent"); asm volatile("s_waitcnt vmcnt(0)" ::: "memory");
        }
        asm volatile("s_waitcnt vmcnt(0) lgkmcnt(0)" ::: "memory"); __builtin_amdgcn_s_barrier(); asm volatile("" ::: "memory");
        if (tid < 256) { float s = 0.f, q = 0.f;
#pragma unroll
            for (int t = 0; t < 8; ++t) { const unsigned long long w = __hip_atomic_load((const unsigned long long*)(xbuf + ((size_t)(u.pm * 8 + t) * 256 + tid) * 2), __ATOMIC_RELAXED, __HIP_MEMORY_SCOPE_AGENT);
                s += __uint_as_float((unsigned)w); q += __uint_as_float((unsigned)(w >> 32)); }
            const float mean = s * (1.f / 2048.f), var = q * (1.f / 2048.f) - mean * mean;
            St[tid] = (f32x2v){mean, 1.0f / sqrtf(fmaxf(var, 0.f) + 1e-5f)}; }
        asm volatile("s_waitcnt lgkmcnt(0)" ::: "memory"); __builtin_amdgcn_s_barrier(); asm volatile("" ::: "memory");
        f32x4 gv[2][2], bv[2][2];
#pragma unroll
        for (int bj = 0; bj < 2; ++bj)
#pragma unroll
            for (int n = 0; n < 2; ++n) { gv[bj][n] = *(const f32x4*)(gam + col0 + bj * HALF + n * 16); bv[bj][n] = *(const f32x4*)(bet + col0 + bj * HALF + n * 16); }
#pragma unroll
        for (int ai = 0; ai < 2; ++ai)
#pragma unroll
            for (int m = 0; m < 4; ++m) {
                const int rl = ai * HALF + wr * 64 + m * 16 + fr; const f32x2v st = St[rl]; const size_t off = (size_t)(u.pm * BM + rl) * ldc + col0;
#pragma unroll
                for (int bj = 0; bj < 2; ++bj)
#pragma unroll
                    for (int n = 0; n < 2; ++n) { const f32x4 y = (acc[ai][bj][m][n] - st.x) * st.y * gv[bj][n] + bv[bj][n];
                        if (outF) __builtin_nontemporal_store(y, (f32x4*)(outF + off + bj * HALF + n * 16));
                        if (outB) { u32x2 w; w.x = ::pk_c(y[0], y[1]); w.y = ::pk_c(y[2], y[3]); *(u32x2*)(outB + off + bj * HALF + n * 16) = w; } }
            }
    }
};
}

__device__ __forceinline__ void transpose_item(const float* W, int K, int ldn, bf16* WT, LAS float* scr, int k0, int n0, int dst_row0, int lane) {
    float tv[32];
#pragma unroll
    for (int i = 0; i < 32; ++i) tv[i] = __builtin_nontemporal_load(W + (size_t)(k0 + 2 * i + (lane >> 5)) * ldn + n0 + (lane & 31));
#pragma unroll
    for (int i = 0; i < 32; ++i) scr[(2 * i + (lane >> 5)) * 33 + (lane & 31)] = tv[i];
    asm volatile("s_waitcnt lgkmcnt(0)" ::: "memory");
    const int c = lane & 7;
#pragma unroll
    for (int j = 0; j < 4; ++j) { const int n = (lane >> 3) + 8 * j; const LAS float* s = scr + (8 * c) * 33 + n;
        u32x4 o; o.x = pk(s[0 * 33], s[1 * 33]); o.y = pk(s[2 * 33], s[3 * 33]); o.z = pk(s[4 * 33], s[5 * 33]); o.w = pk(s[6 * 33], s[7 * 33]);
        *(u32x4*)(WT + (size_t)(dst_row0 + n) * K + k0 + 8 * c) = o; }
    asm volatile("s_waitcnt lgkmcnt(0)" ::: "memory");
}
__device__ __forceinline__ void convert_ffn(const float* w1, const float* w3, const float* w2, bf16* W13, bf16* W2T, LAS float* scr, int gw, int NGW, int lane, int parts = 3) {
    constexpr int I13 = (D / 64) * (FF / 32), I2 = (FF / 64) * (D / 32);
    if (parts & 1) for (int it = gw; it < 2 * I13; it += NGW) { int r = it; const int which = r >= I13; if (which) r -= I13; const int kb = r / (FF / 32), nb = r % (FF / 32), n0 = 32 * nb;
        transpose_item(which ? w3 : w1, D, FF, W13, scr, 64 * kb, n0, (n0 >> 7) * 256 + which * 128 + (n0 & 127), lane); }
    if (parts & 2) for (int r = gw; r < I2; r += NGW) { const int kb = r / (D / 32), nb = r % (D / 32); transpose_item(w2, FF, D, W2T, scr, 64 * kb, 32 * nb, 32 * nb, lane); }
}
template <bool GATES, bool ZERO_SRC>
__device__ __forceinline__ void ln_phase(const float* src, const float* gam, const float* bet, float* dstF, bf16* dstB, const float* Wg, float* G, int gw, int NGW, int lane) {
    f32x4 gv[8], bv[8];
#pragma unroll
    for (int j = 0; j < 8; ++j) { gv[j] = *(const f32x4*)(gam + 4 * lane + 256 * j); bv[j] = *(const f32x4*)(bet + 4 * lane + 256 * j); }
    for (int row = gw; row < M; row += NGW) {
        const float* xr = src + (size_t)row * D + 4 * lane;
        f32x4 v[8]; float s = 0.f;
#pragma unroll
        for (int j = 0; j < 8; ++j) { v[j] = *(const f32x4*)(xr + 256 * j); s += (v[j].x + v[j].y) + (v[j].z + v[j].w); }
        const float mean = wave_sum(s) * (1.f / D); float s2 = 0.f;
#pragma unroll
        for (int j = 0; j < 8; ++j) { v[j] = v[j] - mean; s2 += (v[j].x * v[j].x + v[j].y * v[j].y) + (v[j].z * v[j].z + v[j].w * v[j].w); }
        const float rstd = 1.0f / sqrtf(wave_sum(s2) * (1.f / D) + 1e-5f);
#pragma unroll
        for (int j = 0; j < 8; ++j) v[j] = v[j] * rstd * gv[j] + bv[j];
        if (dstF) {
#pragma unroll
            for (int j = 0; j < 8; ++j) *(f32x4*)(dstF + (size_t)row * D + 4 * lane + 256 * j) = v[j];
        }
        if (dstB) {
#pragma unroll
            for (int j = 0; j < 8; ++j) { u32x2 w; w.x = pk(v[j].x, v[j].y); w.y = pk(v[j].z, v[j].w); *(u32x2*)(dstB + (size_t)row * D + 4 * lane + 256 * j) = w; }
        }
        if (ZERO_SRC) {
#pragma unroll
            for (int j = 0; j < 8; ++j) *(f32x4*)((float*)src + (size_t)row * D + 4 * lane + 256 * j) = (f32x4){0.f, 0.f, 0.f, 0.f};
        }
        if (GATES) {
            float mine = 0.f;
#pragma unroll 1
            for (int jj = 0; jj < 16; ++jj) {
                float a = 0.f;
#pragma unroll
                for (int j = 0; j < 8; ++j) { const f32x4 w = *(const f32x4*)(Wg + jj * D + 4 * lane + 256 * j); a += (v[j].x * w.x + v[j].y * w.y) + (v[j].z * w.z + v[j].w * w.w); }
                a = wave_sum(a); if (lane == jj) mine = a;
            }
            if (lane < 16) G[(size_t)row * 16 + lane] = mine;
        }
    }
}
#define MFMA16(a, b, c) __builtin_amdgcn_mfma_f32_16x16x32_bf16(a, b, c, 0, 0, 0)
#define LBAR() do { asm volatile("s_waitcnt lgkmcnt(0)" ::: "memory"); __builtin_amdgcn_s_barrier(); asm volatile("" ::: "memory"); } while (0)
#define TMAP(i) (dir ? (T - 1 - (i)) : (i))
__device__ __forceinline__ bf16x8 frag(const LAS bf16* base, int row, int stride, int koff) { return *(const LAS bf16x8*)(base + row * stride + koff); }
__device__ __forceinline__ bf16x8 frag_kt(const LAS bf16* base, int row, int chunk) { return *(const LAS bf16x8*)(base + row * 72 + ((chunk ^ ((row >> 1) & 7)) << 3)); }
__device__ __forceinline__ u32x2 pk4(f32x4 v) { u32x2 w; w.x = pk_c(v[0], v[1]); w.y = pk_c(v[2], v[3]); return w; }

__device__ __forceinline__ void hgrn_pre(LAS unsigned char* lds, bf16* Z, const float* hgrn_lb, bf16* AB, float* DEC, int item) {
    const int tid = threadIdx.x, lane = tid & 63, w = __builtin_amdgcn_readfirstlane(tid >> 6);
    const int h = item & 7, c = (item >> 3) & 63, b = item >> 9;
    LAS float* sF = (LAS float*)lds;
    LAS float* sR = sF + 1024;
    const int c0 = 2 * lane;
    float lbf0, lbf1, lbb0, lbb1;
    { const float* lp = hgrn_lb + h * 128 + c0; lbf0 = 1.f / (1.f + expf(lp[1024] - lp[0])); lbf1 = 1.f / (1.f + expf(lp[1025] - lp[1]));
      lbb0 = 1.f / (1.f + expf(lp[2048 + 1024] - lp[2048])); lbb1 = 1.f / (1.f + expf(lp[2048 + 1025] - lp[2049])); }
    bf16* zr = Z + ((size_t)b * T + c * 64 + 8 * w) * ZC + h * 128 + c0;
    unsigned rq[8], rf[8], rb[8];
#pragma unroll
    for (int j = 0; j < 8; ++j) { rq[j] = __builtin_nontemporal_load((const unsigned*)(zr + (size_t)j * ZC)); rf[j] = __builtin_nontemporal_load((const unsigned*)(zr + (size_t)j * ZC + 3072)); rb[j] = __builtin_nontemporal_load((const unsigned*)(zr + (size_t)j * ZC + 4096)); }
    float kf0[8], kf1[8], kb0[8], kb1[8], pf0[8], pf1[8], pb0[8], pb1[8];
    float runf0 = 0.f, runf1 = 0.f;
#pragma unroll
    for (int j = 0; j < 8; ++j) { const float f0 = lbf0 + (1.f - lbf0) * sigm(bflo(rf[j])), f1 = lbf1 + (1.f - lbf1) * sigm(bfhi(rf[j]));
        runf0 += __logf(f0); runf1 += __logf(f1); pf0[j] = runf0; pf1[j] = runf1; kf0[j] = 1.f - f0; kf1[j] = 1.f - f1; }
    float runb0 = 0.f, runb1 = 0.f;
#pragma unroll
    for (int j = 7; j >= 0; --j) { const float f0 = lbb0 + (1.f - lbb0) * sigm(bflo(rb[j])), f1 = lbb1 + (1.f - lbb1) * sigm(bfhi(rb[j]));
        runb0 += __logf(f0); runb1 += __logf(f1); pb0[j] = runb0; pb1[j] = runb1; kb0[j] = 1.f - f0; kb1[j] = 1.f - f1; }
    sF[w * 128 + c0] = runf0; sF[w * 128 + c0 + 1] = runf1; sR[w * 128 + c0] = runb0; sR[w * 128 + c0 + 1] = runb1;
    LBAR();
    float of0 = 0.f, of1 = 0.f, tf0 = 0.f, tf1 = 0.f, ob0 = 0.f, ob1 = 0.f, tb0 = 0.f, tb1 = 0.f;
#pragma unroll
    for (int ww = 0; ww < 8; ++ww) { const float a0 = sF[ww * 128 + c0], a1 = sF[ww * 128 + c0 + 1], d0 = sR[ww * 128 + c0], d1 = sR[ww * 128 + c0 + 1];
        tf0 += a0; tf1 += a1; tb0 += d0; tb1 += d1; if (ww < w) { of0 += a0; of1 += a1; } if (ww > w) { ob0 += d0; ob1 += d1; } }
    bf16* ar = AB + ((size_t)b * T + c * 64 + 8 * w) * 1024 + h * 128 + c0;
#pragma unroll
    for (int j = 0; j < 8; ++j) {
        const float q0 = silu(bflo(rq[j])) * 0.08838834764831845f, q1 = silu(bfhi(rq[j])) * 0.08838834764831845f;
        const float ef0 = of0 + pf0[j] - tf0, ef1 = of1 + pf1[j] - tf1, eb0 = ob0 + pb0[j] - tb0, eb1 = ob1 + pb1[j] - tb1;
        *(unsigned*)(zr + (size_t)j * ZC) = pk_c(q0 * __expf(fminf(ef0, 80.f)), q1 * __expf(fminf(ef1, 80.f)));
        *(unsigned*)(ar + (size_t)j * 1024) = pk_c(q0 * __expf(fminf(eb0, 80.f)), q1 * __expf(fminf(eb1, 80.f)));
        *(unsigned*)(zr + (size_t)j * ZC + 3072) = pk_c(kf0[j] * __expf(-ef0), kf1[j] * __expf(-ef1));
        *(unsigned*)(zr + (size_t)j * ZC + 4096) = pk_c(kb0[j] * __expf(-eb0), kb1[j] * __expf(-eb1));
    }
    if (w == 0) { float* dp = DEC + ((size_t)(b * 2) * 64 + c) * 1024 + h * 128 + c0; dp[0] = __expf(tf0); dp[1] = __expf(tf1); dp[64 * 1024] = __expf(tb0); dp[64 * 1024 + 1] = __expf(tb1); }
    LBAR();
}
__device__ __forceinline__ void mlstm_pre(LAS unsigned char* lds, const bf16* Z, const bf16* XBF, const float* Wg, float* G, const float* conv_w, const float* conv_b, const float* ig_b, const float* fg_b, bf16* QK, bf16* PS, int item) {
    const int tid = threadIdx.x, lane = tid & 63, w = __builtin_amdgcn_readfirstlane(tid >> 6), r = lane & 15, q = lane >> 4;
    const int h = item & 3, c = (item >> 2) & 63, b = item >> 8;
    LAS bf16* sQ = (LAS bf16*)lds;
    LAS bf16* sK = sQ + 64 * 264;
    const int seg = w >> 1, cp = (w & 1) * 64 + lane, c0 = 2 * cp;
    LAS float* sGt = (LAS float*)(lds + 2 * 64 * 264 * 2);
    {
      f32x4 wv[4][8];
#pragma unroll
      for (int g = 0; g < 4; ++g)
#pragma unroll
        for (int j = 0; j < 8; ++j) wv[g][j] = *(const f32x4*)(Wg + (size_t)(4 * g + h) * D + 512 * (j >> 1) + 8 * lane + 4 * (j & 1));
#pragma unroll 1
      for (int rr = 0; rr < 8; ++rr) {
        const size_t row = (size_t)b * T + c * 64 + 8 * w + rr; const bf16* xr = XBF + row * D + 8 * lane; float a[4] = {0.f, 0.f, 0.f, 0.f};
#pragma unroll
        for (int j = 0; j < 4; ++j) { const u32x4 xb = *(const u32x4*)(xr + 512 * j);
            const f32x4 x0 = {bflo(xb.x), bfhi(xb.x), bflo(xb.y), bfhi(xb.y)}, x1 = {bflo(xb.z), bfhi(xb.z), bflo(xb.w), bfhi(xb.w)};
#pragma unroll
            for (int g = 0; g < 4; ++g) a[g] += ((x0.x * wv[g][2 * j].x + x0.y * wv[g][2 * j].y) + (x0.z * wv[g][2 * j].z + x0.w * wv[g][2 * j].w))
                                              + ((x1.x * wv[g][2 * j + 1].x + x1.y * wv[g][2 * j + 1].y) + (x1.z * wv[g][2 * j + 1].z + x1.w * wv[g][2 * j + 1].w)); }
#pragma unroll
        for (int o = 1; o < 64; o <<= 1) {
#pragma unroll
            for (int g = 0; g < 4; ++g) a[g] += __shfl_xor(a[g], o); }
        if (lane == 0) *(LAS f32x4*)(sGt + (8 * w + rr) * 4) = (f32x4){a[0], a[1], a[2], a[3]};
      } }
    LBAR();
    float wq0[5], wq1[5], wk0[5], wk1[5];
#pragma unroll
    for (int j = 0; j < 5; ++j) { const float* cw = conv_w + j * 2048 + h * 256 + c0; wq0[j] = cw[0]; wq1[j] = cw[1]; wk0[j] = cw[1024]; wk1[j] = cw[1025]; }
    const float bq0 = conv_b[h * 256 + c0], bq1 = conv_b[h * 256 + c0 + 1], bk0 = conv_b[1024 + h * 256 + c0], bk1 = conv_b[1024 + h * 256 + c0 + 1];
    const bf16* zq = Z + (size_t)b * T * ZC + 5120 + h * 256;
    const bf16* zk = Z + (size_t)b * T * ZC + 6144 + h * 256;
    unsigned xq[20], xk[20];
#pragma unroll
    for (int m = 0; m < 20; ++m) { const int t = c * 64 + 16 * seg - 2 + m; const bool ok = (t >= 0) && (t < T); const size_t tt = (size_t)(ok ? t : 0);
        const unsigned a = __builtin_nontemporal_load((const unsigned*)(zq + tt * ZC + c0)), d = __builtin_nontemporal_load((const unsigned*)(zk + tt * ZC + c0)); xq[m] = ok ? a : 0u; xk[m] = ok ? d : 0u; }
    float igF, igB, bcF, bcB;
    { const f32x4 gl = *(const LAS f32x4*)(sGt + lane * 4);
      igF = gl.x + ig_b[h]; igB = gl.y + ig_b[4 + h];
      const float mfF = gl.z + fg_b[h], mfB = gl.w + fg_b[4 + h];
      bcF = mfF >= 0.f ? -log1pf(expf(-mfF)) : mfF - log1pf(expf(mfF));
      bcB = mfB >= 0.f ? -log1pf(expf(-mfB)) : mfB - log1pf(expf(mfB));
#pragma unroll
      for (int o = 1; o < 64; o <<= 1) { const float u = __shfl_up(bcF, o), v = __shfl_down(bcB, o); if (lane >= o) bcF += u; if (lane + o < 64) bcB += v; } }
    const float blF = __shfl(bcF, 63), blB = __shfl(bcB, 0);
    if (w == 0) { float* go = G + ((size_t)b * T + c * 64 + lane) * 16 + h; go[0] = __expf(blF - bcF + igF); go[4] = __expf(blB - bcB + igB); go[8] = bcF; go[12] = bcB; }
    bf16* orow = QK + ((size_t)b * T + c * 64 + 16 * seg) * 2048 + h * 256 + c0;
#pragma unroll
    for (int il = 0; il < 16; ++il) {
        float aq0 = bq0, aq1 = bq1, ak0 = bk0, ak1 = bk1;
#pragma unroll
        for (int j = 0; j < 5; ++j) { aq0 += wq0[j] * bflo(xq[il + j]); aq1 += wq1[j] * bfhi(xq[il + j]); ak0 += wk0[j] * bflo(xk[il + j]); ak1 += wk1[j] * bfhi(xk[il + j]); }
        const unsigned qv = pk_c(silu(aq0) * 0.0625f, silu(aq1) * 0.0625f), kv = pk_c(silu(ak0), silu(ak1));
        *(unsigned*)(orow + (size_t)il * 2048) = qv; *(unsigned*)(orow + (size_t)il * 2048 + 1024) = kv;
        *(LAS unsigned*)(sQ + (16 * seg + il) * 264 + c0) = qv; *(LAS unsigned*)(sK + (16 * seg + il) * 264 + c0) = kv;
    }
    LBAR();
    const int ti = w >> 1;
    bf16* pf = PS + ((size_t)((b * 4 + h) * 64 + c) * 2) * 4096; bf16* pb = pf + 4096;
#pragma unroll
    for (int jj = 0; jj < 2; ++jj) {
        const int sj = (w & 1) * 2 + jj;
        f32x4 acc = {0.f, 0.f, 0.f, 0.f};
#pragma unroll
        for (int kk = 0; kk < 8; ++kk) acc = MFMA16(frag(sK, 16 * sj + r, 264, 32 * kk + 8 * q), frag(sQ, 16 * ti + r, 264, 32 * kk + 8 * q), acc);
        const int t = 16 * ti + r, s0 = 16 * sj + 4 * q;
        const float eF = __expf(__shfl(bcF, t) - blF), eB = __expf(__shfl(bcB, t) - blB);
        f32x4 vf, vb;
#pragma unroll
        for (int i = 0; i < 4; ++i) { const int sx = s0 + i; vf[i] = (sx <= t) ? acc[i] * eF : 0.f; vb[3 - i] = (sx >= t) ? acc[i] * eB : 0.f; }
        *(u32x2*)(pf + t * 64 + s0) = pk4(vf);
        *(u32x2*)(pb + (63 - t) * 64 + (60 - s0)) = pk4(vb);
    }
    LBAR();
}

__device__ __forceinline__ void hgrn_scan(LAS unsigned char* lds, const bf16* Z, const bf16* AB, const float* DEC, float* O, bf16* OB, int item) {
    const int tid = threadIdx.x, lane = tid & 63, w = __builtin_amdgcn_readfirstlane(tid >> 6), r = lane & 15, q = lane >> 4;
    const int sl = item & 3, dir = (item >> 2) & 1, h = (item >> 3) & 7, b = item >> 6;
    LAS bf16* sA = (LAS bf16*)lds;
    LAS bf16* sB = sA + 64 * 136;
    LAS bf16* sKd = sB + 64 * 136;
    LAS bf16* sVT = sKd + 128 * 72;
    LAS bf16* sP = sVT + 32 * 72;
    LAS bf16* sST = sP + 64 * 72;
    for (int i = tid; i < 32 * 136 / 2; i += 512) ((LAS unsigned*)sST)[i] = 0u;
    LBAR();
    const int c0 = 2 * lane;
    const bf16* za = dir ? AB + (size_t)b * T * 1024 + h * 128 : Z + (size_t)b * T * ZC + h * 128;
    const size_t lda = dir ? 1024 : ZC;
    const bf16* zk = Z + (size_t)b * T * ZC + 3072 + dir * 1024 + h * 128;
    const int vp = lane & 15, vseg = (w & 1) * 4 + (lane >> 4);
    const bf16* zv = Z + (size_t)b * T * ZC + 1024 + h * 128 + sl * 32;
    const float* decp = DEC + ((size_t)(b * 2 + dir) * 64) * 1024 + h * 128 + 16 * w + 4 * q;
    const size_t obase = (size_t)b * T * D + h * 128 + sl * 32;
    f32x4 Sacc[2] = {{0.f, 0.f, 0.f, 0.f}, {0.f, 0.f, 0.f, 0.f}};
    unsigned ra[8], rk[8], rv[8]; f32x4 dcur, dnxt;
#define HG_LOAD(ci_) do { _Pragma("unroll") for (int j = 0; j < 8; ++j) { const size_t t_ = (size_t)TMAP((ci_) * 64 + 8 * w + j); ra[j] = *(const unsigned*)(za + t_ * lda + c0); rk[j] = *(const unsigned*)(zk + t_ * ZC + c0); } \
        if (w < 2) { _Pragma("unroll") for (int j = 0; j < 8; ++j) rv[j] = __builtin_nontemporal_load((const unsigned*)(zv + (size_t)TMAP((ci_) * 64 + 8 * vseg + j) * ZC + 2 * vp)); } } while (0)
#define HG_DEC(ci_) (*(const f32x4*)(decp + (size_t)(dir ? 63 - (ci_) : (ci_)) * 1024))
    HG_LOAD(0); dcur = HG_DEC(0);
    const int ti = w >> 1, ej = w & 1;
    for (int ci = 0; ci < 64; ++ci) {
#pragma unroll
        for (int j = 0; j < 8; ++j) { const int i = 8 * w + j; *(LAS unsigned*)(sA + i * 136 + c0) = ra[j]; *(LAS unsigned*)(sB + i * 136 + c0) = rk[j]; }
        { u32x4 a, c;
          a.x = (rk[0] & 0xffffu) | (rk[1] << 16); a.y = (rk[2] & 0xffffu) | (rk[3] << 16); a.z = (rk[4] & 0xffffu) | (rk[5] << 16); a.w = (rk[6] & 0xffffu) | (rk[7] << 16);
          c.x = (rk[0] >> 16) | (rk[1] & 0xffff0000u); c.y = (rk[2] >> 16) | (rk[3] & 0xffff0000u); c.z = (rk[4] >> 16) | (rk[5] & 0xffff0000u); c.w = (rk[6] >> 16) | (rk[7] & 0xffff0000u);
          const int cs = (w ^ (lane & 7)) << 3; *(LAS u32x4*)(sKd + c0 * 72 + cs) = a; *(LAS u32x4*)(sKd + (c0 + 1) * 72 + cs) = c; }
        if (w < 2) { u32x4 a, c; const int cs = (vseg ^ (vp & 7)) << 3;
          a.x = (rv[0] & 0xffffu) | (rv[1] << 16); a.y = (rv[2] & 0xffffu) | (rv[3] << 16); a.z = (rv[4] & 0xffffu) | (rv[5] << 16); a.w = (rv[6] & 0xffffu) | (rv[7] << 16);
          c.x = (rv[0] >> 16) | (rv[1] & 0xffff0000u); c.y = (rv[2] >> 16) | (rv[3] & 0xffff0000u); c.z = (rv[4] >> 16) | (rv[5] & 0xffff0000u); c.w = (rv[6] >> 16) | (rv[7] & 0xffff0000u);
          *(LAS u32x4*)(sVT + (2 * vp) * 72 + cs) = a; *(LAS u32x4*)(sVT + (2 * vp + 1) * 72 + cs) = c; }
        LBAR();
        if (ci + 1 < 64) { HG_LOAD(ci + 1); dnxt = HG_DEC(ci + 1); } else dnxt = dcur;
#pragma unroll
        for (int jj = 0; jj < 2; ++jj) {
            const int sj = (w & 1) * 2 + jj; u32x2 pw; pw.x = 0u; pw.y = 0u;
            if (sj <= ti) {
                f32x4 acc = {0.f, 0.f, 0.f, 0.f};
#pragma unroll
                for (int kk = 0; kk < 4; ++kk) acc = MFMA16(frag(sB, 16 * sj + r, 136, 32 * kk + 8 * q), frag(sA, 16 * ti + r, 136, 32 * kk + 8 * q), acc);
                const int t = 16 * ti + r, s0 = 16 * sj + 4 * q;
#pragma unroll
                for (int i = 0; i < 4; ++i) acc[i] = (s0 + i <= t) ? acc[i] : 0.f;
                pw = pk4(acc);
            }
            *(LAS u32x2*)(sP + (16 * ti + r) * 72 + 16 * sj + 4 * q) = pw;
        }
        f32x4 o = {0.f, 0.f, 0.f, 0.f};
#pragma unroll
        for (int kk = 0; kk < 4; ++kk) o = MFMA16(frag(sA, 16 * ti + r, 136, 32 * kk + 8 * q), frag(sST, 16 * ej + r, 136, 32 * kk + 8 * q), o);
        LBAR();
#pragma unroll
        for (int kk = 0; kk < 2; ++kk) o = MFMA16(frag(sP, 16 * ti + r, 72, 32 * kk + 8 * q), frag_kt(sVT, 16 * ej + r, 4 * kk + q), o);
#pragma unroll
        for (int i = 0; i < 4; ++i) { const size_t t = (size_t)TMAP(ci * 64 + 16 * ti + 4 * q + i); const size_t oi = obase + t * D + 16 * ej + r; (dir ? OB : (bf16*)O)[oi] = (bf16)(pk_c(o[i], 0.f) & 0xffffu); }
#pragma unroll
        for (int e2 = 0; e2 < 2; ++e2) {
            Sacc[e2] = Sacc[e2] * dcur;
#pragma unroll
            for (int kk = 0; kk < 2; ++kk) Sacc[e2] = MFMA16(frag_kt(sKd, 16 * w + r, 4 * kk + q), frag_kt(sVT, 16 * e2 + r, 4 * kk + q), Sacc[e2]);
            *(LAS u32x2*)(sST + (16 * e2 + r) * 136 + 16 * w + 4 * q) = pk4(Sacc[e2] * dnxt);
        }
        dcur = dnxt;
        LBAR();
    }
#undef HG_LOAD
#undef HG_DEC
}

__device__ __forceinline__ void mlstm_scan(LAS unsigned char* lds, const bf16* Z, const float* G, const float* conv_w, const float* conv_b, const float* ig_b, const float* fg_b, float* O, bf16* OB, const bf16* QK, const bf16* PS, int item) {
    const int tid = threadIdx.x, lane = tid & 63, w = __builtin_amdgcn_readfirstlane(tid >> 6), r = lane & 15, q = lane >> 4;
    const int sl = item & 7, dir = (item >> 3) & 1, h = (item >> 4) & 3, b = item >> 6;
    LAS bf16* sQ = (LAS bf16*)lds;
    LAS bf16* sKT = sQ + 64 * 264;
    LAS bf16* sVT = sKT + 256 * 72;
    LAS bf16* sVw = sVT + 34 * 72;
    LAS bf16* sP = sVw + 34 * 72;
    LAS bf16* sCT0 = sP + 64 * 72;
    for (int i = tid; i < 2 * 34 * 264 / 2; i += 512) ((LAS unsigned*)sCT0)[i] = 0u;
    for (int i = tid; i < 2 * 34 * 72 / 2; i += 512) ((LAS unsigned*)sVT)[i] = 0u;
    LBAR();
    const int r2 = 32 + (r ? 1 : 0);
    const int seg = w >> 1, cp = (w & 1) * 64 + lane, c0 = 2 * cp;
    const bf16* zq = QK + (size_t)b * T * 2048 + h * 256;
    const bf16* zk = zq + 1024;
    const bf16* pp = PS + ((size_t)((b * 4 + h) * 64) * 2 + dir) * 4096 + tid * 8;
    const int vp = lane & 15, vseg = (w & 1) * 4 + (lane >> 4);
    const bf16* zv = Z + (size_t)b * T * ZC + 7168 + h * 256 + sl * 32;
    const float* gp = G + (size_t)b * T * 16 + dir * 4 + h;
    const float igb = ig_b[dir * 4 + h], fgb = fg_b[dir * 4 + h];
    const size_t obase = (size_t)b * T * D + 1024 + h * 256 + sl * 32;
    f32x4 Cacc[2][3];
#pragma unroll
    for (int a = 0; a < 2; ++a)
#pragma unroll
        for (int c = 0; c < 3; ++c) Cacc[a][c] = (f32x4){0.f, 0.f, 0.f, 0.f};
    unsigned xq[2][16], xk[2][16], rv[8]; u32x4 rp; float gws, gbc, wsv[8];
#define ML_LOAD(ci_, S_) do { _Pragma("unroll") for (int m = 0; m < 16; ++m) { const size_t t_ = (size_t)TMAP((ci_) * 64 + 16 * seg + m); xq[S_][m] = *(const unsigned*)(zq + t_ * 2048 + c0); xk[S_][m] = *(const unsigned*)(zk + t_ * 2048 + c0); } } while (0)
#define ML_LOAD2(ci_) do { if (w < 2) { _Pragma("unroll") for (int j = 0; j < 8; ++j) { const size_t t_ = (size_t)TMAP((ci_) * 64 + 8 * vseg + j); rv[j] = __builtin_nontemporal_load((const unsigned*)(zv + t_ * ZC + 2 * vp)); wsv[j] = gp[t_ * 16]; } } \
        rp = *(const u32x4*)(pp + (size_t)(dir ? 63 - (ci_) : (ci_)) * 8192); \
        { const size_t t_ = (size_t)TMAP((ci_) * 64 + lane); gws = gp[t_ * 16]; gbc = gp[t_ * 16 + 8]; } } while (0)
    ML_LOAD(0, 0); ML_LOAD2(0); ML_LOAD(1, 1);
    const int ti = w >> 1, ej = w & 1;
    for (int cc = 0; cc < 64; cc += 2) {
#pragma unroll
      for (int half = 0; half < 2; ++half) {
        const int ci = cc + half;
        const LAS bf16* sCT = sCT0 + half * (34 * 264); LAS bf16* sCTn = sCT0 + (half ^ 1) * (34 * 264);
        const float bc = gbc;
        const float blast = __shfl(bc, 63);
        if (w == 0) { sVw[32 * 72 + lane] = (bf16)(pk_c(gws, 0.f) & 0xffffu); }
#pragma unroll
        for (int m = 0; m < 16; ++m) *(LAS unsigned*)(sQ + (16 * seg + m) * 264 + c0) = xq[half][m];
        *(LAS u32x4*)(sP + (tid >> 3) * 72 + (tid & 7) * 8) = rp;
#pragma unroll
        for (int u = 0; u < 2; ++u) { u32x4 a, c; const int cs = ((2 * seg + u) ^ (lane & 7)) << 3;
            a.x = (xk[half][8 * u + 0] & 0xffffu) | (xk[half][8 * u + 1] << 16); a.y = (xk[half][8 * u + 2] & 0xffffu) | (xk[half][8 * u + 3] << 16); a.z = (xk[half][8 * u + 4] & 0xffffu) | (xk[half][8 * u + 5] << 16); a.w = (xk[half][8 * u + 6] & 0xffffu) | (xk[half][8 * u + 7] << 16);
            c.x = (xk[half][8 * u + 0] >> 16) | (xk[half][8 * u + 1] & 0xffff0000u); c.y = (xk[half][8 * u + 2] >> 16) | (xk[half][8 * u + 3] & 0xffff0000u); c.z = (xk[half][8 * u + 4] >> 16) | (xk[half][8 * u + 5] & 0xffff0000u); c.w = (xk[half][8 * u + 6] >> 16) | (xk[half][8 * u + 7] & 0xffff0000u);
            *(LAS u32x4*)(sKT + c0 * 72 + cs) = a; *(LAS u32x4*)(sKT + (c0 + 1) * 72 + cs) = c; }
        if (w < 2) { u32x4 aw, cw; const int cs = (vseg ^ (vp & 7)) << 3;
          aw.x = pk(bflo(rv[0]) * wsv[0], bflo(rv[1]) * wsv[1]); aw.y = pk(bflo(rv[2]) * wsv[2], bflo(rv[3]) * wsv[3]); aw.z = pk(bflo(rv[4]) * wsv[4], bflo(rv[5]) * wsv[5]); aw.w = pk(bflo(rv[6]) * wsv[6], bflo(rv[7]) * wsv[7]);
          cw.x = pk(bfhi(rv[0]) * wsv[0], bfhi(rv[1]) * wsv[1]); cw.y = pk(bfhi(rv[2]) * wsv[2], bfhi(rv[3]) * wsv[3]); cw.z = pk(bfhi(rv[4]) * wsv[4], bfhi(rv[5]) * wsv[5]); cw.w = pk(bfhi(rv[6]) * wsv[6], bfhi(rv[7]) * wsv[7]);
          *(LAS u32x4*)(sVw + (2 * vp) * 72 + cs) = aw; *(LAS u32x4*)(sVw + (2 * vp + 1) * 72 + cs) = cw; }
        LBAR();
        if (ci + 2 < 64) ML_LOAD(ci + 2, half);
        if (ci + 1 < 64) ML_LOAD2(ci + 1);
        __builtin_amdgcn_sched_barrier(0);
        f32x4 o1 = {0.f, 0.f, 0.f, 0.f}, o2 = {0.f, 0.f, 0.f, 0.f};
#pragma unroll
        for (int kk = 0; kk < 8; ++kk) { const bf16x8 a = frag(sQ, 16 * ti + r, 264, 32 * kk + 8 * q);
            o1 = MFMA16(a, frag(sCT, 16 * ej + r, 264, 32 * kk + 8 * q), o1); o2 = MFMA16(a, frag(sCT, r2, 264, 32 * kk + 8 * q), o2);
            if (kk & 1) __builtin_amdgcn_sched_barrier(0); }
#pragma unroll
        for (int i = 0; i < 4; ++i) { const float e = __expf(__shfl(bc, 16 * ti + 4 * q + i)); o1[i] *= e; o2[i] *= e; }
#pragma unroll
        for (int kk = 0; kk < 2; ++kk) { const bf16x8 a = frag(sP, 16 * ti + r, 72, 32 * kk + 8 * q);
            o1 = MFMA16(a, frag_kt(sVw, 16 * ej + r, 4 * kk + q), o1); o2 = MFMA16(a, frag_kt(sVw, r2, 4 * kk + q), o2); }
#pragma unroll
        for (int i = 0; i < 4; ++i) { const float dn = __shfl(o2[i], lane & 48); const size_t t = (size_t)TMAP(ci * 64 + 16 * ti + 4 * q + i);
            const float hv = o1[i] / fmaxf(fabsf(dn), 1.f); const size_t oi = obase + t * D + 16 * ej + r; (dir ? OB : (bf16*)O)[oi] = (bf16)(pk_c(hv, 0.f) & 0xffffu); }
        const float dec = __expf(blast);
#pragma unroll
        for (int dt = 0; dt < 2; ++dt)
#pragma unroll
            for (int et = 0; et < 3; ++et) {
                Cacc[dt][et] = Cacc[dt][et] * dec;
#pragma unroll
                for (int kk = 0; kk < 2; ++kk) Cacc[dt][et] = MFMA16(frag_kt(sKT, 16 * (2 * w + dt) + r, 4 * kk + q), frag_kt(sVw, et < 2 ? 16 * et + r : r2, 4 * kk + q), Cacc[dt][et]);
                if (et < 2 || r == 0) *(LAS u32x2*)(sCTn + (16 * et + r) * 264 + 16 * (2 * w + dt) + 4 * q) = pk4(Cacc[dt][et]);
            }
        LBAR();
      }
    }
#undef ML_LOAD
#undef ML_LOAD2
}
__device__ __forceinline__ void finalize_phase(const bf16* O, const bf16* OB, const bf16* Z, const float* hg_g, const float* ml_g, bf16* Y, int gw, int NGW, int lane) {
    for (int row = gw; row < M; row += NGW) {
        u32x4 oa4[4], ob4[4], gz4[4];
#pragma unroll
        for (int jc = 0; jc < 4; ++jc) { const int col = 512 * jc + 8 * lane;
            oa4[jc] = __builtin_nontemporal_load((const u32x4*)(O + (size_t)row * D + col)); ob4[jc] = __builtin_nontemporal_load((const u32x4*)(OB + (size_t)row * D + col));
            gz4[jc] = __builtin_nontemporal_load((const u32x4*)(Z + (size_t)row * ZC + (jc < 2 ? 2048 + col : 8192 + col - 1024))); }
#pragma unroll
        for (int jc = 0; jc < 4; ++jc) {
            const int col = 512 * jc + 8 * lane;
            const u32x4 oa = oa4[jc], ob = ob4[jc];
            const f32x4 a = {bflo(oa.x), bfhi(oa.x), bflo(oa.y), bfhi(oa.y)}, c = {bflo(oa.z), bfhi(oa.z), bflo(oa.w), bfhi(oa.w)};
            float o[8] = {a.x + bflo(ob.x), a.y + bfhi(ob.x), a.z + bflo(ob.y), a.w + bfhi(ob.y), c.x + bflo(ob.z), c.y + bfhi(ob.z), c.z + bflo(ob.w), c.w + bfhi(ob.w)};
            const u32x4 gz = gz4[jc];
            const float gt[8] = {bflo(gz.x), bfhi(gz.x), bflo(gz.y), bfhi(gz.y), bflo(gz.z), bfhi(gz.z), bflo(gz.w), bfhi(gz.w)};
            const float* gp = jc < 2 ? hg_g + col : ml_g + col - 1024;
            const f32x4 g0 = *(const f32x4*)gp, g1 = *(const f32x4*)(gp + 4);
            const float gg[8] = {g0.x, g0.y, g0.z, g0.w, g1.x, g1.y, g1.z, g1.w};
            float y[8];
            if (jc < 2) {
                float ss = 0.f;
#pragma unroll
                for (int j = 0; j < 8; ++j) ss += o[j] * o[j];
                ss += __shfl_xor(ss, 1); ss += __shfl_xor(ss, 2); ss += __shfl_xor(ss, 4); ss += __shfl_xor(ss, 8);
                const float rs = 1.0f / sqrtf(ss * (1.f / 128.f) + 1e-6f);
#pragma unroll
                for (int j = 0; j < 8; ++j) y[j] = o[j] * rs * gg[j] * silu(gt[j]);
            } else {
                float s = 0.f;
#pragma unroll
                for (int j = 0; j < 8; ++j) s += o[j];
                s += __shfl_xor(s, 1); s += __shfl_xor(s, 2); s += __shfl_xor(s, 4); s += __shfl_xor(s, 8); s += __shfl_xor(s, 16);
                const float mu = s * (1.f / 256.f); float ss = 0.f;
#pragma unroll
                for (int j = 0; j < 8; ++j) { o[j] -= mu; ss += o[j] * o[j]; }
                ss += __shfl_xor(ss, 1); ss += __shfl_xor(ss, 2); ss += __shfl_xor(ss, 4); ss += __shfl_xor(ss, 8); ss += __shfl_xor(ss, 16);
                const float rs = 1.0f / sqrtf(ss * (1.f / 256.f) + 1e-6f);
#pragma unroll
                for (int j = 0; j < 8; ++j) y[j] = o[j] * rs * gg[j] * sigm(gt[j]);
            }
            u32x4 w; w.x = pk(y[0], y[1]); w.y = pk(y[2], y[3]); w.z = pk(y[4], y[5]); w.w = pk(y[6], y[7]);
            *(u32x4*)(Y + (size_t)row * D + col) = w;
        }
    }
}

#define GB_CENSUS(j) (64 * (j))
#define GB_ARR(j) (1024 + 64 * (j))
#define GB_GEN(j) (2048 + 64 * (j))
#define GB_TOP 3072
#define GB_TOPGEN 3136
#define GB_WORDS 3200
__device__ __forceinline__ unsigned gb_ld(unsigned* p) { return __hip_atomic_load(p, __ATOMIC_RELAXED, __HIP_MEMORY_SCOPE_AGENT); }
__device__ __forceinline__ unsigned gb_xcc() { return (unsigned)__builtin_amdgcn_s_getreg((3 << 11) | 20) & 0xFu; }
__device__ __forceinline__ void grid_bar(unsigned* bw, unsigned k, volatile LAS unsigned* cen) {
    asm volatile("s_waitcnt vmcnt(0) lgkmcnt(0)" ::: "memory");
    __syncthreads();
    if (threadIdx.x == 0) {
        const unsigned x = gb_xcc(), nloc = cen[0], nx = cen[1];
        const unsigned old = __hip_atomic_fetch_add(bw + GB_ARR(x), 1u, __ATOMIC_RELAXED, __HIP_MEMORY_SCOPE_AGENT);
        if (old + 1u == k * nloc) {
            __builtin_amdgcn_fence(__ATOMIC_RELEASE, "agent");
            asm volatile("s_waitcnt vmcnt(0)" ::: "memory");
            const unsigned oldt = __hip_atomic_fetch_add(bw + GB_TOP, 1u, __ATOMIC_RELAXED, __HIP_MEMORY_SCOPE_AGENT);
            if (oldt + 1u == k * nx) __hip_atomic_store(bw + GB_TOPGEN, k, __ATOMIC_RELAXED, __HIP_MEMORY_SCOPE_AGENT);
            else while (gb_ld(bw + GB_TOPGEN) < k) __builtin_amdgcn_s_sleep(1);
            __hip_atomic_store(bw + GB_GEN(x), k, __ATOMIC_RELAXED, __HIP_MEMORY_SCOPE_AGENT);
        } else while (gb_ld(bw + GB_GEN(x)) < k) __builtin_amdgcn_s_sleep(1);
        __builtin_amdgcn_fence(__ATOMIC_ACQUIRE, "agent");
        asm volatile("s_waitcnt vmcnt(0)" ::: "memory");
    }
    __syncthreads();
}
#ifndef REP_SCAN
#define REP_SCAN 1
#endif
#ifndef REP_GEMM
#define REP_GEMM 1
#endif
struct Args { const float* in[22]; float* out; unsigned char* ws; int ph_lo, ph_hi; };
constexpr int NPH = 12;
__global__ void __launch_bounds__(512, 2) mk_fwd(Args a) {
    extern __shared__ __attribute__((aligned(16))) unsigned char lds_raw[];
    LAS unsigned char* lds = (LAS unsigned char*)lds_raw;
    cg::grid_group grid = cg::this_grid();
    const int tid = threadIdx.x, lane = tid & 63, wave = __builtin_amdgcn_readfirstlane(tid >> 6);
    const int G_ = gridDim.x, bx = blockIdx.x, vcu = (G_ % 8 == 0) ? (bx % 8) * (G_ / 8) + bx / 8 : bx;
    const int gw = vcu * 8 + wave, NGW = G_ * 8;
    const float* x = a.in[0];
    const float *f1w1 = a.in[1], *f1w3 = a.in[2], *f1w2 = a.in[3], *ln1g = a.in[4], *ln1b = a.in[5], *w_in = a.in[6], *hgrn_lb = a.in[7], *hgrn_g = a.in[8],
                *conv_w = a.in[9], *conv_b = a.in[10], *ig_b = a.in[11], *fg_b = a.in[12], *ml_g = a.in[13], *w_out = a.in[14], *ln2g = a.in[15], *ln2b = a.in[16],
                *f2w1 = a.in[17], *f2w3 = a.in[18], *f2w2 = a.in[19], *ln3g = a.in[20], *ln3b = a.in[21];
    unsigned char* ws = a.ws; float* out = a.out;
    bf16 *W13 = (bf16*)(ws + WS_W13), *W2T = (bf16*)(ws + WS_W2), *WinT = (bf16*)(ws + WS_WIN), *WoutT = (bf16*)(ws + WS_WOUT);
    float *Wg = (float*)(ws + WS_WG), *Gt = (float*)(ws + WS_G), *XF = (float*)(ws + WS_XF);
    bf16 *XB = (bf16*)(ws + WS_XB), *Zb = (bf16*)(ws + WS_ZH), *Hb = (bf16*)(ws + WS_ZH), *Yb = (bf16*)(ws + WS_Y), *ABb = (bf16*)(ws + WS_AB);
    float* DEC = (float*)(ws + WS_DEC); bf16* PSb = (bf16*)(ws + WS_PS);
    LAS float* scr = (LAS float*)(lds + wave * 16384);
    const int lo = a.ph_lo, hi = a.ph_hi;
#ifdef PHMASK
#define IN(k) (((PHMASK >> (k)) & 1) && lo <= (k) && (k) < hi)
#else
#define IN(k) (lo <= (k) && (k) < hi)
#endif
    unsigned* bar_ctr = (unsigned*)(ws + 32768);
    unsigned* pan_cnt = (unsigned*)(ws + 4096);
    if (bx == 0) { for (int i = tid; i < GB_WORDS / 64 + 1; i += 512) __hip_atomic_store(bar_ctr + 64 * i, 0u, __ATOMIC_RELAXED, __HIP_MEMORY_SCOPE_AGENT);
                   if (tid < 96) __hip_atomic_store(pan_cnt + 64 * tid, 0u, __ATOMIC_RELAXED, __HIP_MEMORY_SCOPE_AGENT); }
    unsigned bar_n = 0;
    volatile LAS unsigned* cen = (volatile LAS unsigned*)(lds + LDS_BYTES - 16);
#define CENSUS() do { if (tid == 0) { const unsigned x_ = gb_xcc(); __hip_atomic_fetch_add(bar_ctr + GB_CENSUS(x_), 1u, __ATOMIC_RELAXED, __HIP_MEMORY_SCOPE_AGENT); \
        unsigned sum_, mine_, nx_; do { sum_ = 0u; mine_ = 0u; nx_ = 0u; _Pragma("unroll") for (unsigned j_ = 0; j_ < 16; ++j_) { const unsigned c_ = gb_ld(bar_ctr + GB_CENSUS(j_)); sum_ += c_; nx_ += (c_ != 0u); mine_ = (j_ == x_) ? c_ : mine_; } \
            if (sum_ != (unsigned)G_) __builtin_amdgcn_s_sleep(1); } while (sum_ != (unsigned)G_); \
        cen[0] = mine_; cen[1] = nx_; } __syncthreads(); } while (0)
#define SEAM(k) do { if (IN(k) && IN((k) + 1)) { if ((k) == 0) { grid.sync(); CENSUS(); } else { ++bar_n; grid_bar(bar_ctr, bar_n, cen); } } } while (0)

    if (IN(0)) {
        convert_ffn(f1w1, f1w3, f1w2, W13, W2T, scr, gw, NGW, lane);
        for (int row = gw; row < M; row += NGW) {
#pragma unroll
            for (int j = 0; j < 8; ++j) { const f32x4 v = __builtin_nontemporal_load((const f32x4*)(x + (size_t)row * D + 4 * lane + 256 * j)); u32x2 w; w.x = pk(v.x, v.y); w.y = pk(v.z, v.w);
                *(u32x2*)(XB + (size_t)row * D + 4 * lane + 256 * j) = w; }
        }
        __syncthreads();
    }
    SEAM(0);
    if (IN(1)) { pg8::Gemm g{XB, W13, M, 2 * FF, D}; pg8::StaticOrder S; S.init(M, 2 * FF, G_, bx); pg8::EpiSwiglu E{Hb, FF};
        for (int rep = 0; rep < REP_GEMM; ++rep) pg8::gemm_phase<pg8::EpiSwiglu, pg8::StaticOrder, true, true>(lds, g, S, E);
        if (G_ != 256 || bx >= 128) { const int dgw = (G_ == 256) ? (bx - 128) * 8 + wave : gw, dngw = (G_ == 256) ? 128 * 8 : NGW;
        constexpr int IIN = (D / 64) * (ZC / 32), IOUT = (D / 64) * (D / 32);
        for (int it = dgw; it < IIN + IOUT; it += dngw) {
            if (it < IIN) { const int kb = it / (ZC / 32), nb = it % (ZC / 32); transpose_item(w_in, D, INC, WinT, scr, 64 * kb, 32 * nb, 32 * nb, lane); }
            else { const int r = it - IIN, kb = r / (D / 32), nb = r % (D / 32); transpose_item(w_out, D, D, WoutT, scr, 64 * kb, 32 * nb, 32 * nb, lane); }
        }
        for (int i = dgw * 64 + lane; i < 16 * D; i += dngw * 64) { const int k = i >> 4, j = i & 15; Wg[j * D + k] = w_in[(size_t)k * INC + ZC + j]; }
        }
        __syncthreads(); }
    SEAM(1);
    if (IN(2)) { pg8::Gemm g{Hb, W2T, M, D, FF}; pg8::StaticOrder S; S.init(M, D, G_, bx);
        if (G_ == 256) { pg8::EpiResLN E{XB, x, ALPHA, 0.5f, ln1g, ln1b, nullptr, XB, (float*)(ws + WS_X3), pan_cnt + 64 * 64};
            pg8::gemm_phase<pg8::EpiResLN, pg8::StaticOrder, false, true>(lds, g, S, E); }
        else { pg8::EpiRes E{x, out, D, ALPHA, 0.5f}; pg8::gemm_phase<pg8::EpiRes, pg8::StaticOrder, true, true>(lds, g, S, E); } }
    if (G_ != 256) { SEAM(2);
    if (IN(3)) { ln_phase<true, false>(out, ln1g, ln1b, XF, XB, Wg, Gt, gw, NGW, lane); } }
    SEAM(3);
    if (IN(4)) { pg8::Gemm g{XB, WinT, M, ZC, D}; pg8::EpiPlain E{Zb, ZC};
        if (G_ == 256) { pg8::MapOrder S; S.init(M, 32, G_, bx, 8, 0, 4); pg8::gemm_phase<pg8::EpiPlain, pg8::MapOrder, true, true>(lds, g, S, E); }
        else { pg8::StaticOrder S; S.init(M, ZC, G_, bx); pg8::gemm_phase<pg8::EpiPlain, pg8::StaticOrder, true, true>(lds, g, S, E); convert_ffn(f2w1, f2w3, f2w2, W13, W2T, scr, gw, NGW, lane); }
        __syncthreads(); }
    SEAM(4);
    bf16* OBp = (bf16*)out + (size_t)M * D;
    if (IN(5)) {
        for (int it = vcu; it < 1536; it += G_) { if (it < 1024) hgrn_pre(lds, Zb, hgrn_lb, ABb, DEC, it); else mlstm_pre(lds, Zb, XB, Wg, Gt, conv_w, conv_b, ig_b, fg_b, Yb, PSb, it - 1024); }
        ++bar_n; grid_bar(bar_ctr, bar_n, cen);
    }
    if (IN(5)) for (int rep = 0; rep < REP_SCAN; ++rep) {
        for (int it = vcu; it < 256; it += G_) {
            if (it < 128) hgrn_scan(lds, Zb, ABb, DEC, out, OBp, it);
            else mlstm_scan(lds, Zb, Gt, conv_w, conv_b, ig_b, fg_b, out, OBp, Yb, PSb, it - 128);
        }
    }
    if (IN(5) && G_ == 256 && vcu < 128) { __syncthreads();
        pg8::Gemm g{XB, WinT, M, ZC, D}; pg8::EpiPlain E{Zb, ZC}; pg8::MapOrder S; S.init(M, 4, 128, 8 * (vcu & 15) + 2 * (vcu >> 5) + ((vcu >> 4) & 1), 4, 8, 8);
        pg8::gemm_phase<pg8::EpiPlain, pg8::MapOrder, true, true>(lds, g, S, E); __syncthreads();
        convert_ffn(f2w1, f2w3, f2w2, W13, W2T, scr, vcu * 8 + wave, 128 * 8, lane, 1); }
    SEAM(5);
    if (IN(6)) finalize_phase((const bf16*)out, OBp, Zb, hgrn_g, ml_g, Yb, gw, NGW, lane);
    SEAM(6);
    if (IN(7)) { pg8::Gemm g{Yb, WoutT, M, D, D}; pg8::StaticOrder S; S.init(M, D, G_, bx);
        if (G_ == 256) { pg8::EpiResLN E{XB, nullptr, ALPHA, 1.0f, ln2g, ln2b, nullptr, XB, (float*)(ws + WS_G + 512 * 1024), pan_cnt};
            pg8::gemm_phase<pg8::EpiResLN, pg8::StaticOrder, false, true>(lds, g, S, E); }
        else { pg8::EpiRes E{XF, out, D, ALPHA, 1.0f}; pg8::gemm_phase<pg8::EpiRes, pg8::StaticOrder, true, true>(lds, g, S, E); } }
    if (G_ != 256) { SEAM(7);
    if (IN(8)) ln_phase<false, false>(out, ln2g, ln2b, XF, XB, nullptr, nullptr, gw, NGW, lane); }
    SEAM(8);
    if (IN(9)) { pg8::Gemm g{XB, W13, M, 2 * FF, D}; pg8::StaticOrder S; S.init(M, 2 * FF, G_, bx); pg8::EpiSwiglu E{Hb, FF};
        pg8::gemm_phase<pg8::EpiSwiglu, pg8::StaticOrder, true, true>(lds, g, S, E);
        if (G_ == 256 && bx >= 128) convert_ffn(f2w1, f2w3, f2w2, W13, W2T, scr, (bx - 128) * 8 + wave, 128 * 8, lane, 2);
        __syncthreads(); }
    SEAM(9);
    if (IN(10)) { pg8::Gemm g{Hb, W2T, M, D, FF}; pg8::StaticOrder S; S.init(M, D, G_, bx);
        if (G_ == 256) { pg8::EpiResLN E{XB, nullptr, ALPHA, 0.5f, ln3g, ln3b, out, nullptr, (float*)(ws + WS_WG + 512 * 1024), pan_cnt + 64 * 32};
            pg8::gemm_phase<pg8::EpiResLN, pg8::StaticOrder, false, true>(lds, g, S, E); }
        else { pg8::EpiRes E{XF, out, D, ALPHA, 0.5f}; pg8::gemm_phase<pg8::EpiRes, pg8::StaticOrder, true, true>(lds, g, S, E); } }
    if (G_ != 256) { SEAM(10);
    if (IN(11)) ln_phase<false, false>(out, ln3g, ln3b, out, nullptr, nullptr, nullptr, gw, NGW, lane); }
#undef IN
#undef SEAM
}

#ifndef MK_N_LAUNCHES
#define MK_N_LAUNCHES 1
#endif
extern "C" void kernel_launch(void* const* d_in, const int* in_sizes, int n_in, void* d_out, int out_size, void* d_ws, size_t ws_size, hipStream_t stream) {
    static int grid = 0;
    if (grid == 0) {
        if (n_in != 22 || in_sizes[0] != M * D || out_size != M * D || ws_size < WS_END) { fprintf(stderr, "kernel_launch: unexpected shapes / workspace (n_in %d, ws %zu, need %zu)\n", n_in, ws_size, (size_t)WS_END); grid = -1; return; }
        int dev = 0, cus = 0, per_cu = 0;
        hipGetDevice(&dev); hipDeviceGetAttribute(&cus, hipDeviceAttributeMultiprocessorCount, dev);
        if (hipFuncSetAttribute((const void*)mk_fwd, hipFuncAttributeMaxDynamicSharedMemorySize, LDS_BYTES) != hipSuccess) { fprintf(stderr, "kernel_launch: hipFuncSetAttribute failed\n"); grid = -1; return; }
        if (hipOccupancyMaxActiveBlocksPerMultiprocessor(&per_cu, (const void*)mk_fwd, 512, LDS_BYTES) != hipSuccess || per_cu < 1) { fprintf(stderr, "kernel_launch: occupancy query failed (%d)\n", per_cu); (void)hipGetLastError(); per_cu = 1; }
        grid = cus * (per_cu > 1 ? 1 : per_cu);
        fprintf(stderr, "kernel_launch: grid %d (cus %d, per_cu %d), ws %zu\n", grid, cus, per_cu, ws_size);
    }
    if (grid < 0) return;
    Args a{};
    for (int i = 0; i < 22; ++i) a.in[i] = (const float*)d_in[i];
    a.out = (float*)d_out; a.ws = (unsigned char*)d_ws;
    for (int li = 0; li < MK_N_LAUNCHES; ++li) {
        a.ph_lo = (MK_N_LAUNCHES == 1) ? 0 : li; a.ph_hi = (MK_N_LAUNCHES == 1) ? NPH : li + 1;
        void* args[] = {&a};
        hipError_t e = hipLaunchCooperativeKernel((const void*)mk_fwd, dim3(grid), dim3(512), args, LDS_BYTES, stream);
        if (e != hipSuccess) { fprintf(stderr, "kernel_launch: cooperative launch failed: %s (grid %d)\n", hipGetErrorString(e), grid); break; }
    }
}
```

```cpp
#include <hip/hip_runtime.h>
#include <hip/hip_cooperative_groups.h>
#include <cstdio>
#include <cstdint>
namespace cg = cooperative_groups;
namespace pg8 {
#define PG8_LAS __attribute__((address_space(3)))
typedef unsigned short bf16_t;
typedef short bf16x8 __attribute__((ext_vector_type(8)));
typedef float f32x4 __attribute__((ext_vector_type(4)));
typedef unsigned u32x4 __attribute__((ext_vector_type(4)));
constexpr int BM = 256, BK = 64, HALF = 128, HTB = HALF * BK * 2  , STAGE_BYTES = 8 * HTB, NXCD = 8, WGM = 8;

__host__ __device__ __forceinline__ int lds_byte(int r, int c) { const int st = (r >> 4) * 2 + (c >> 5), rr = r & 15, cc = c & 31, ob = rr * 64 + cc * 2; return st * 1024 + (ob ^ (((ob >> 9) & 1) << 5)); }
__host__ __device__ __forceinline__ void stage_rc(int b, int& R, int& C) { const int st = b / 1024, sb = b % 1024, swz = sb ^ (((sb >> 9) & 1) << 5); R = (st >> 1) * 16 + swz / 64; C = (st & 1) * 32 + (swz % 64) / 2; }
__host__ __device__ __forceinline__ int perm32(int rho) { const int n = rho >> 4, i = rho & 15; return 8 * (i >> 2) + 4 * n + (i & 3); }

struct Unit { int pm, pn; };
struct Gemm { const bf16_t* A; const bf16_t* Bt; int M, N, K; };

struct StaticOrder {
    int nM, nN, nwg, G, c;
    __host__ __device__ void init(int M, int N, int G_, int c_) { nM = M / BM; nN = N / BM; nwg = nM * nN; G = G_; c = c_; }
    __host__ __device__ bool next(int i, Unit& u) const {
        const long L = (long)i * G + c; if (L >= nwg) return false;
        int wgid = (int)L; { const int q = nwg / NXCD, r = nwg % NXCD, xcd = wgid % NXCD, off = wgid / NXCD; wgid = (xcd < r ? xcd * (q + 1) : r * (q + 1) + (xcd - r) * q) + off; }
        const int nig = WGM * nN, gid = wgid / nig, fm = gid * WGM, gsz = (nM - fm) < WGM ? (nM - fm) : WGM;
        u.pm = fm + ((wgid % nig) % gsz); u.pn = (wgid % nig) / gsz; return true;
    }
    __device__ __forceinline__ void a_ready(const Unit&) const {}
    __device__ __forceinline__ void done(const Unit&) const {}
};

__device__ __forceinline__ unsigned cvt_pk_bf16(float lo, float hi) { unsigned r; asm volatile("v_cvt_pk_bf16_f32 %0, %1, %2" : "=v"(r) : "v"(lo), "v"(hi)); return r; }
typedef float f32x2 __attribute__((ext_vector_type(2)));
template <class Epi, class Sched, bool ALIGN_EPI = false, bool SP2 = false>
__device__ __forceinline__ void gemm_phase(PG8_LAS unsigned char* lds, const Gemm g, const Sched& S, const Epi& E) {
    const int tid = threadIdx.x, wid = __builtin_amdgcn_readfirstlane(tid >> 6), lane = tid & 63, wr = wid >> 2, wc = wid & 3, fr = lane & 15, fq = lane >> 4;
    const int K = g.K, nt = K / BK;
    unsigned voffA[2], voffB[2];
#pragma unroll
    for (int i = 0; i < 2; ++i) { int R, C; stage_rc(tid * 16 + i * 8192, R, C); const int Rb = Epi::PERM ? ((R & ~31) + perm32(R & 31)) : R;
        voffA[i] = (unsigned)(R * K + C) * 2u; voffB[i] = (unsigned)(Rb * K + C) * 2u; }
    const size_t kstep = (size_t)(BK * 2);
    const size_t hstep = (size_t)HALF * K * 2;
    const size_t tstep = 2 * hstep;
    const unsigned ldsw = (unsigned)wid * 1024u;
    const int aoff = lds_byte(wr * 64 + fr, fq * 8), boff = lds_byte(wc * 32 + fr, fq * 8);
#define PG8_SA(b, h) (((b) * 2 + (h)) * HTB)
#define PG8_SB(b, h) ((4 + (b) * 2 + (h)) * HTB)
#define PG8_STAGE(bufoff, gbase, voff) do { _Pragma("unroll") for (int _i = 0; _i < 2; ++_i) \
        __builtin_amdgcn_global_load_lds((const unsigned*)((const char*)(gbase) + (voff)[_i]), (PG8_LAS unsigned*)(lds + (bufoff) + ldsw + _i * 8192), 16, 0, 0); } while (0)
#define PG8_LDA(dst, b, h) do { _Pragma("unroll") for (int m = 0; m < 4; ++m) _Pragma("unroll") for (int k = 0; k < 2; ++k) dst[m][k] = *(const PG8_LAS bf16x8*)(lds + PG8_SA(b, h) + aoff + m * 2048 + k * 1024); } while (0)
#define PG8_LDB(dst, b, h) do { _Pragma("unroll") for (int n = 0; n < 2; ++n) _Pragma("unroll") for (int k = 0; k < 2; ++k) dst[n][k] = *(const PG8_LAS bf16x8*)(lds + PG8_SB(b, h) + boff + n * 2048 + k * 1024); } while (0)
#define PG8_MMA(ai, bj, At, Bt) do { __builtin_amdgcn_s_setprio(1); _Pragma("unroll") for (int m = 0; m < 4; ++m) _Pragma("unroll") for (int n = 0; n < 2; ++n) _Pragma("unroll") for (int k = 0; k < 2; ++k) \
        acc[ai][bj][m][n] = __builtin_amdgcn_mfma_f32_16x16x32_bf16(Bt[n][k], At[m][k], acc[ai][bj][m][n], 0, 0, 0); __builtin_amdgcn_s_setprio(0); } while (0)
#define PG8_WAIT_V(n) asm volatile("s_waitcnt vmcnt(" #n ")" ::: "memory")
#define PG8_WAIT_L(n) asm volatile("s_waitcnt lgkmcnt(" #n ")" ::: "memory")
#define PG8_BAR __builtin_amdgcn_s_barrier()
#define PG8_SCHED __builtin_amdgcn_sched_barrier(0)
    Unit cur, nxt; int ui = 0;
    if (!S.next(0, cur)) return;
    f32x4 acc[2][2][4][2];
#pragma unroll
    for (int a = 0; a < 2; ++a)
#pragma unroll
        for (int b = 0; b < 2; ++b)
#pragma unroll
            for (int m = 0; m < 4; ++m)
#pragma unroll
                for (int n = 0; n < 2; ++n) acc[a][b][m][n] = (f32x4){0.f, 0.f, 0.f, 0.f};
    bf16x8 At[4][2], B0[2][2], B1[2][2];
    const char* cA = (const char*)g.A + (size_t)cur.pm * tstep; const char* cB = (const char*)g.Bt + (size_t)cur.pn * tstep;
    S.a_ready(cur);
    if constexpr (SP2) {
        PG8_STAGE(PG8_SB(0, 0), cB, voffB); PG8_STAGE(PG8_SB(0, 1), cB + hstep, voffB); PG8_STAGE(PG8_SA(0, 0), cA, voffA); PG8_STAGE(PG8_SA(0, 1), cA + hstep, voffA);
        if (wr == 1) PG8_BAR;
        PG8_WAIT_V(2); PG8_BAR;
        PG8_STAGE(PG8_SB(1, 0), cB + kstep, voffB); PG8_STAGE(PG8_SA(1, 0), cA + kstep, voffA); PG8_STAGE(PG8_SB(1, 1), cB + hstep + kstep, voffB);
        PG8_WAIT_V(6); PG8_BAR;
    } else {
        PG8_STAGE(PG8_SB(0, 0), cB, voffB); PG8_STAGE(PG8_SA(0, 0), cA, voffA); PG8_STAGE(PG8_SB(0, 1), cB + hstep, voffB); PG8_STAGE(PG8_SA(0, 1), cA + hstep, voffA);
        if (wr == 1) PG8_BAR;
        PG8_WAIT_V(4); PG8_BAR;
        PG8_STAGE(PG8_SB(1, 0), cB + kstep, voffB); PG8_STAGE(PG8_SA(1, 0), cA + kstep, voffA); PG8_STAGE(PG8_SB(1, 1), cB + hstep + kstep, voffB);
        PG8_WAIT_V(6); PG8_BAR;
    }
    for (;;) {
        const bool has_next = S.next(ui + 1, nxt);
        const char* nA = has_next ? (const char*)g.A + (size_t)nxt.pm * tstep : cA; const char* nB = has_next ? (const char*)g.Bt + (size_t)nxt.pn * tstep : cB;
        for (int t = 0; t < nt; t += 2) {
            const bool last = (t == nt - 2);
            const char* a1 = cA + (size_t)(t + 1) * kstep;
            const char* a2 = last ? nA : cA + (size_t)(t + 2) * kstep; const char* b2 = last ? nB : cB + (size_t)(t + 2) * kstep;
            const char* a3 = a2 + kstep; const char* b3 = b2 + kstep;
            if (last && has_next) S.a_ready(nxt);
            if constexpr (SP2) {
            PG8_LDB(B0, 0, 0); PG8_LDB(B1, 0, 1); PG8_SCHED; PG8_LDA(At, 0, 0); PG8_STAGE(PG8_SA(1, 1), a1 + hstep, voffA);
            PG8_WAIT_V(8); PG8_WAIT_L(0); PG8_BAR; PG8_MMA(0, 0, At, B0); PG8_MMA(0, 1, At, B1); PG8_BAR; PG8_SCHED;
            PG8_LDA(At, 0, 1); PG8_STAGE(PG8_SB(0, 0), b2, voffB); PG8_STAGE(PG8_SB(0, 1), b2 + hstep, voffB); PG8_STAGE(PG8_SA(0, 0), a2, voffA);
            PG8_WAIT_V(8); PG8_WAIT_L(0); PG8_BAR; PG8_MMA(1, 0, At, B0); PG8_MMA(1, 1, At, B1); PG8_BAR; PG8_SCHED;
            PG8_LDB(B0, 1, 0); PG8_LDB(B1, 1, 1); PG8_SCHED; PG8_LDA(At, 1, 0); PG8_STAGE(PG8_SA(0, 1), a2 + hstep, voffA);
            PG8_WAIT_V(8); PG8_WAIT_L(0); PG8_BAR; PG8_MMA(0, 0, At, B0); PG8_MMA(0, 1, At, B1); PG8_BAR; PG8_SCHED;
            PG8_LDA(At, 1, 1); PG8_STAGE(PG8_SB(1, 0), b3, voffB); PG8_STAGE(PG8_SB(1, 1), b3 + hstep, voffB); PG8_STAGE(PG8_SA(1, 0), a3, voffA);
            PG8_WAIT_V(8); PG8_WAIT_L(0); PG8_BAR; PG8_MMA(1, 0, At, B0); PG8_MMA(1, 1, At, B1); PG8_BAR; PG8_SCHED;
            } else {
            PG8_LDB(B0, 0, 0); PG8_SCHED; PG8_LDA(At, 0, 0); PG8_STAGE(PG8_SA(1, 1), a1 + hstep, voffA);
            PG8_WAIT_L(8); PG8_BAR; PG8_WAIT_L(0); PG8_MMA(0, 0, At, B0); PG8_BAR; PG8_SCHED;
            PG8_LDB(B1, 0, 1); PG8_STAGE(PG8_SB(0, 0), b2, voffB);
            PG8_BAR; PG8_WAIT_L(0); PG8_MMA(0, 1, At, B1); PG8_BAR;
            PG8_LDA(At, 0, 1); PG8_STAGE(PG8_SA(0, 0), a2, voffA);
            PG8_BAR; PG8_WAIT_L(0); PG8_MMA(1, 0, At, B0); PG8_BAR; PG8_SCHED;
            PG8_STAGE(PG8_SB(0, 1), b2 + hstep, voffB);
            PG8_WAIT_V(6); PG8_BAR; PG8_MMA(1, 1, At, B1); PG8_BAR;
            PG8_LDB(B0, 1, 0); PG8_SCHED; PG8_LDA(At, 1, 0); PG8_STAGE(PG8_SA(0, 1), a2 + hstep, voffA);
            PG8_WAIT_L(8); PG8_BAR; PG8_WAIT_L(0); PG8_MMA(0, 0, At, B0); PG8_BAR; PG8_SCHED;
            PG8_LDB(B1, 1, 1); PG8_STAGE(PG8_SB(1, 0), b3, voffB);
            PG8_BAR; PG8_WAIT_L(0); PG8_MMA(0, 1, At, B1); PG8_BAR;
            PG8_LDA(At, 1, 1); PG8_STAGE(PG8_SA(1, 0), a3, voffA);
            PG8_BAR; PG8_WAIT_L(0); PG8_MMA(1, 0, At, B0); PG8_BAR; PG8_SCHED;
            PG8_STAGE(PG8_SB(1, 1), b3 + hstep, voffB);
            PG8_WAIT_V(6); PG8_BAR; PG8_MMA(1, 1, At, B1); PG8_BAR;
            }
        }
        if constexpr (ALIGN_EPI) { if (wr == 0) PG8_BAR; }
        if constexpr (!Epi::AFTER_DRAIN) { E(acc, cur, wr, wc, fr, fq); S.done(cur); }
        if (!has_next) break;
#pragma unroll
        for (int a = 0; a < 2; ++a)
#pragma unroll
            for (int b = 0; b < 2; ++b)
#pragma unroll
                for (int m = 0; m < 4; ++m)
#pragma unroll
                    for (int n = 0; n < 2; ++n) acc[a][b][m][n] = (f32x4){0.f, 0.f, 0.f, 0.f};
        cur = nxt; cA = nA; cB = nB; ++ui;
        if constexpr (ALIGN_EPI) { if (wr == 1) PG8_BAR; }
    }
    PG8_WAIT_V(0);
    if constexpr (!ALIGN_EPI) { if (wr == 0) PG8_BAR; }
    PG8_BAR;
    if constexpr (Epi::AFTER_DRAIN) { E.fused(acc, cur, wr, wc, fr, fq, lds, wid, lane); S.done(cur); }
#undef PG8_SA
#undef PG8_SB
#undef PG8_STAGE
#undef PG8_LDA
#undef PG8_LDB
#undef PG8_MMA
#undef PG8_WAIT_V
#undef PG8_WAIT_L
#undef PG8_BAR
#undef PG8_SCHED
}
}
#define LAS __attribute__((address_space(3)))
typedef unsigned short bf16;
typedef float f32x4 __attribute__((ext_vector_type(4)));
typedef short bf16x8 __attribute__((ext_vector_type(8)));
typedef unsigned u32x4 __attribute__((ext_vector_type(4)));
typedef unsigned u32x2 __attribute__((ext_vector_type(2)));
constexpr int T = 4096, M = 8192, D = 2048, FF = 5632, ZC = 9216, INC = 9232;
constexpr float ALPHA = 1.189207115002721f;
constexpr size_t MiB = 1u << 20;
constexpr size_t WS_W13 = 1 * MiB, WS_W2 = 45 * MiB, WS_WIN = 67 * MiB, WS_WOUT = 103 * MiB, WS_WG = 111 * MiB, WS_G = 112 * MiB,
                 WS_XF = 113 * MiB, WS_XB = 177 * MiB, WS_ZH = 209 * MiB, WS_Y = 353 * MiB, WS_AB = 385 * MiB, WS_DEC = 401 * MiB, WS_PS = 402 * MiB, WS_X3 = 410 * MiB, WS_END = 411 * MiB;
constexpr int LDS_BYTES = 147456;

__device__ __forceinline__ float bf2f(unsigned short h) { return __uint_as_float((unsigned)h << 16); }
__device__ __forceinline__ float bflo(unsigned u) { return __uint_as_float(u << 16); }
__device__ __forceinline__ float bfhi(unsigned u) { return __uint_as_float(u & 0xffff0000u); }
typedef float f32x2_t __attribute__((ext_vector_type(2)));
typedef __bf16 bf16x2_t __attribute__((ext_vector_type(2)));
__device__ __forceinline__ unsigned pk_c(float lo, float hi) { f32x2_t v = {lo, hi}; bf16x2_t b = __builtin_convertvector(v, bf16x2_t); return __builtin_bit_cast(unsigned, b); }
__device__ __forceinline__ unsigned pk(float lo, float hi) { return pg8::cvt_pk_bf16(lo, hi); }
__device__ __forceinline__ float sigm(float x) { return __builtin_amdgcn_rcpf(1.f + __expf(-x)); }
__device__ __forceinline__ float silu(float x) { return x * sigm(x); }
__device__ __forceinline__ float wave_sum(float v) {
#pragma unroll
    for (int o = 1; o < 64; o <<= 1) v += __shfl_xor(v, o);
    return v;
}

namespace pg8 {
struct MapOrder {
    StaticOrder S; int split, off0, off1;
    __device__ void init(int M, int ncols, int G_, int c_, int split_, int off0_, int off1_) { S.init(M, ncols * BM, G_, c_); split = split_; off0 = off0_; off1 = off1_; }
    __device__ bool next(int i, Unit& u) const { if (!S.next(i, u)) return false; u.pn += (u.pn < split) ? off0 : off1; return true; }
    __device__ __forceinline__ void a_ready(const Unit&) const {}
    __device__ __forceinline__ void done(const Unit&) const {}
};
struct EpiSwiglu {
    static constexpr bool PERM = true, AFTER_DRAIN = false;
    bf16_t* H; int ldh;
    __device__ __forceinline__ void operator()(const f32x4 (&acc)[2][2][4][2], const Unit& u, int wr, int wc, int fr, int fq) const {
        const int row0 = u.pm * BM + wr * 64 + fr, col0 = u.pn * HALF + wc * 32 + 8 * fq;
#pragma unroll
        for (int ai = 0; ai < 2; ++ai)
#pragma unroll
            for (int m = 0; m < 4; ++m) {
                const f32x4 g0 = acc[ai][0][m][0], g1 = acc[ai][0][m][1], u0 = acc[ai][1][m][0], u1 = acc[ai][1][m][1];
                u32x4 w;
                w.x = cvt_pk_bf16(silu(g0[0]) * u0[0], silu(g0[1]) * u0[1]); w.y = cvt_pk_bf16(silu(g0[2]) * u0[2], silu(g0[3]) * u0[3]);
                w.z = cvt_pk_bf16(silu(g1[0]) * u1[0], silu(g1[1]) * u1[1]); w.w = cvt_pk_bf16(silu(g1[2]) * u1[2], silu(g1[3]) * u1[3]);
                *(u32x4*)(H + (size_t)(row0 + ai * HALF + m * 16) * ldh + col0) = w;
            }
    }
};
struct EpiPlain {
    static constexpr bool PERM = true, AFTER_DRAIN = false;
    bf16_t* O; int ldc;
    __device__ __forceinline__ void operator()(const f32x4 (&acc)[2][2][4][2], const Unit& u, int wr, int wc, int fr, int fq) const {
        const int row0 = u.pm * BM + wr * 64 + fr, col0 = u.pn * BM + wc * 32 + 8 * fq;
#pragma unroll
        for (int ai = 0; ai < 2; ++ai)
#pragma unroll
            for (int m = 0; m < 4; ++m)
#pragma unroll
                for (int bj = 0; bj < 2; ++bj) {
                    const f32x4 v0 = acc[ai][bj][m][0], v1 = acc[ai][bj][m][1];
                    u32x4 w; w.x = cvt_pk_bf16(v0[0], v0[1]); w.y = cvt_pk_bf16(v0[2], v0[3]); w.z = cvt_pk_bf16(v1[0], v1[1]); w.w = cvt_pk_bf16(v1[2], v1[3]);
                    *(u32x4*)(O + (size_t)(row0 + ai * HALF + m * 16) * ldc + col0 + bj * HALF) = w;
                }
    }
};
struct EpiRes {
    static constexpr bool PERM = false, AFTER_DRAIN = false;
    const float* res; float* out; int ldc; float ra, sa;
    __device__ __forceinline__ void operator()(const f32x4 (&acc)[2][2][4][2], const Unit& u, int wr, int wc, int fr, int fq) const {
        const int row0 = u.pm * BM + wr * 64 + fr, col0 = u.pn * BM + wc * 32 + 4 * fq;
#pragma unroll
        for (int ai = 0; ai < 2; ++ai)
#pragma unroll
            for (int m = 0; m < 4; ++m) {
                const size_t off = (size_t)(row0 + ai * HALF + m * 16) * ldc + col0;
#pragma unroll
                for (int bj = 0; bj < 2; ++bj)
#pragma unroll
                    for (int n = 0; n < 2; ++n) {
                        const f32x4 r = *(const f32x4*)(res + off + bj * HALF + n * 16);
                        *(f32x4*)(out + off + bj * HALF + n * 16) = r * ra + acc[ai][bj][m][n] * sa;
                    }
            }
    }
};
struct EpiResLN {
    static constexpr bool PERM = false, AFTER_DRAIN = true;
    const bf16_t* res; const float* resF; float ra, sa; const float* gam; const float* bet; float* outF; bf16_t* outB; float* xbuf; unsigned* cnt;
    __device__ __forceinline__ void fused(f32x4 (&acc)[2][2][4][2], const Unit& u, int wr, int wc, int fr, int fq, PG8_LAS unsigned char* lds, int wid, int lane) const {
        typedef float f32x2v __attribute__((ext_vector_type(2)));
        PG8_LAS f32x2v* Pst = (PG8_LAS f32x2v*)lds;
        PG8_LAS f32x2v* St = (PG8_LAS f32x2v*)(lds + 8192);
        const int row0 = u.pm * BM + wr * 64 + fr, col0 = u.pn * BM + wc * 32 + 4 * fq, ldc = 2048;
        f32x4 rr[4][4];
#define RES_LOAD(g_) do { const size_t off_ = (size_t)(row0 + ((g_) >> 2) * HALF + ((g_) & 3) * 16) * ldc + col0; \
            _Pragma("unroll") for (int bj = 0; bj < 2; ++bj) _Pragma("unroll") for (int n = 0; n < 2; ++n) { if (resF) rr[(g_) & 3][bj * 2 + n] = __builtin_nontemporal_load((const f32x4*)(resF + off_ + bj * HALF + n * 16)); \
              else { const u32x2 t_ = __builtin_nontemporal_load((const u32x2*)(res + off_ + bj * HALF + n * 16)); rr[(g_) & 3][bj * 2 + n] = (f32x4){::bflo(t_.x), ::bfhi(t_.x), ::bflo(t_.y), ::bfhi(t_.y)}; } } } while (0)
        RES_LOAD(0); RES_LOAD(1); RES_LOAD(2); RES_LOAD(3);
#pragma unroll
        for (int g = 0; g < 8; ++g) {
            const int ai = g >> 2, m = g & 3; float s = 0.f, q = 0.f;
#pragma unroll
            for (int bj = 0; bj < 2; ++bj)
#pragma unroll
                for (int n = 0; n < 2; ++n) { const f32x4 v = rr[g & 3][bj * 2 + n] * ra + acc[ai][bj][m][n] * sa; acc[ai][bj][m][n] = v;
                    s += (v[0] + v[1]) + (v[2] + v[3]); q += (v[0] * v[0] + v[1] * v[1]) + (v[2] * v[2] + v[3] * v[3]); }
            if (g + 4 < 8) RES_LOAD(g + 4);
            s += __shfl_xor(s, 16); s += __shfl_xor(s, 32); q += __shfl_xor(q, 16); q += __shfl_xor(q, 32);
            if (fq == 0) Pst[(ai * HALF + wr * 64 + m * 16 + fr) * 4 + wc] = (f32x2v){s, q};
        }
#undef RES_LOAD
        asm volatile("s_waitcnt lgkmcnt(0)" ::: "memory"); __builtin_amdgcn_s_barrier(); asm volatile("" ::: "memory");
        const int tid = wid * 64 + lane;
        if (tid < 256) { const f32x2v a = Pst[tid * 4 + 0], b = Pst[tid * 4 + 1], c = Pst[tid * 4 + 2], d = Pst[tid * 4 + 3];
            const float ps = (a.x + b.x) + (c.x + d.x), pq = (a.y + b.y) + (c.y + d.y);
            __hip_atomic_store((unsigned long long*)(xbuf + ((size_t)(u.pm * 8 + u.pn) * 256 + tid) * 2), ((unsigned long long)__float_as_uint(pq) << 32) | __float_as_uint(ps), __ATOMIC_RELAXED, __HIP_MEMORY_SCOPE_AGENT); }
        asm volatile("s_waitcnt vmcnt(0) lgkmcnt(0)" ::: "memory"); __builtin_amdgcn_s_barrier(); asm volatile("" ::: "memory");
        if (tid == 0) {
            __hip_atomic_fetch_add(cnt + 64 * u.pm, 1u, __ATOMIC_RELAXED, __HIP_MEMORY_SCOPE_AGENT);
            while (__hip_atomic_load(cnt + 64 * u.pm, __ATOMIC_RELAXED, __HIP_MEMORY_SCOPE_AGENT) < 8u) __builtin_amdgcn_s_sleep(1);
            __builtin_amdgcn_fence(__ATOMIC_ACQUIRE, "agent"); asm volatile("s_waitcnt vmcnt(0)" ::: "memory");
        }
        asm volatile("s_waitcnt vmcnt(0) lgkmcnt(0)" ::: "memory"); __builtin_amdgcn_s_barrier(); asm volatile("" ::: "memory");
        if (tid < 256) { float s = 0.f, q = 0.f;
#pragma unroll
            for (int t = 0; t < 8; ++t) { const unsigned long long w = __hip_atomic_load((const unsigned long long*)(xbuf + ((size_t)(u.pm * 8 + t) * 256 + tid) * 2), __ATOMIC_RELAXED, __HIP_MEMORY_SCOPE_AGENT);
                s += __uint_as_float((unsigned)w); q += __uint_as_float((unsigned)(w >> 32)); }
            const float mean = s * (1.f / 2048.f), var = q * (1.f / 2048.f) - mean * mean;
            St[tid] = (f32x2v){mean, 1.0f / sqrtf(fmaxf(var, 0.f) + 1e-5f)}; }
        asm volatile("s_waitcnt lgkmcnt(0)" ::: "memory"); __builtin_amdgcn_s_barrier(); asm volatile("" ::: "memory");
        f32x4 gv[2][2], bv[2][2];
#pragma unroll
        for (int bj = 0; bj < 2; ++bj)
#pragma unroll
            for (int n = 0; n < 2; ++n) { gv[bj][n] = *(const f32x4*)(gam + col0 + bj * HALF + n * 16); bv[bj][n] = *(const f32x4*)(bet + col0 + bj * HALF + n * 16); }
#pragma unroll
        for (int ai = 0; ai < 2; ++ai)
#pragma unroll
            for (int m = 0; m < 4; ++m) {
                const int rl = ai * HALF + wr * 64 + m * 16 + fr; const f32x2v st = St[rl]; const size_t off = (size_t)(u.pm * BM + rl) * ldc + col0;
#pragma unroll
                for (int bj = 0; bj < 2; ++bj)
#pragma unroll
                    for (int n = 0; n < 2; ++n) { const f32x4 y = (acc[ai][bj][m][n] - st.x) * st.y * gv[bj][n] + bv[bj][n];
                        if (outF) __builtin_nontemporal_store(y, (f32x4*)(outF + off + bj * HALF + n * 16));
                        if (outB) { u32x2 w; w.x = ::pk_c(y[0], y[1]); w.y = ::pk_c(y[2], y[3]); *(u32x2*)(outB + off + bj * HALF + n * 16) = w; } }
            }
    }
};
}

__device__ __forceinline__ void transpose_item(const float* W, int K, int ldn, bf16* WT, LAS float* scr, int k0, int n0, int dst_row0, int lane) {
    float tv[32];
#pragma unroll
    for (int i = 0; i < 32; ++i) tv[i] = __builtin_nontemporal_load(W + (size_t)(k0 + 2 * i + (lane >> 5)) * ldn + n0 + (lane & 31));
#pragma unroll
    for (int i = 0; i < 32; ++i) scr[(2 * i + (lane >> 5)) * 33 + (lane & 31)] = tv[i];
    asm volatile("s_waitcnt lgkmcnt(0)" ::: "memory");
    const int c = lane & 7;
#pragma unroll
    for (int j = 0; j < 4; ++j) { const int n = (lane >> 3) + 8 * j; const LAS float* s = scr + (8 * c) * 33 + n;
        u32x4 o; o.x = pk(s[0 * 33], s[1 * 33]); o.y = pk(s[2 * 33], s[3 * 33]); o.z = pk(s[4 * 33], s[5 * 33]); o.w = pk(s[6 * 33], s[7 * 33]);
        *(u32x4*)(WT + (size_t)(dst_row0 + n) * K + k0 + 8 * c) = o; }
    asm volatile("s_waitcnt lgkmcnt(0)" ::: "memory");
}
__device__ __forceinline__ void convert_ffn(const float* w1, const float* w3, const float* w2, bf16* W13, bf16* W2T, LAS float* scr, int gw, int NGW, int lane, int parts = 3) {
    constexpr int I13 = (D / 64) * (FF / 32), I2 = (FF / 64) * (D / 32);
    if (parts & 1) for (int it = gw; it < 2 * I13; it += NGW) { int r = it; const int which = r >= I13; if (which) r -= I13; const int kb = r / (FF / 32), nb = r % (FF / 32), n0 = 32 * nb;
        transpose_item(which ? w3 : w1, D, FF, W13, scr, 64 * kb, n0, (n0 >> 7) * 256 + which * 128 + (n0 & 127), lane); }
    if (parts & 2) for (int r = gw; r < I2; r += NGW) { const int kb = r / (D / 32), nb = r % (D / 32); transpose_item(w2, FF, D, W2T, scr, 64 * kb, 32 * nb, 32 * nb, lane); }
}
template <bool GATES, bool ZERO_SRC>
__device__ __forceinline__ void ln_phase(const float* src, const float* gam, const float* bet, float* dstF, bf16* dstB, const float* Wg, float* G, int gw, int NGW, int lane) {
    f32x4 gv[8], bv[8];
#pragma unroll
    for (int j = 0; j < 8; ++j) { gv[j] = *(const f32x4*)(gam + 4 * lane + 256 * j); bv[j] = *(const f32x4*)(bet + 4 * lane + 256 * j); }
    for (int row = gw; row < M; row += NGW) {
        const float* xr = src + (size_t)row * D + 4 * lane;
        f32x4 v[8]; float s = 0.f;
#pragma unroll
        for (int j = 0; j < 8; ++j) { v[j] = *(const f32x4*)(xr + 256 * j); s += (v[j].x + v[j].y) + (v[j].z + v[j].w); }
        const float mean = wave_sum(s) * (1.f / D); float s2 = 0.f;
#pragma unroll
        for (int j = 0; j < 8; ++j) { v[j] = v[j] - mean; s2 += (v[j].x * v[j].x + v[j].y * v[j].y) + (v[j].z * v[j].z + v[j].w * v[j].w); }
        const float rstd = 1.0f / sqrtf(wave_sum(s2) * (1.f / D) + 1e-5f);
#pragma unroll
        for (int j = 0; j < 8; ++j) v[j] = v[j] * rstd * gv[j] + bv[j];
        if (dstF) {
#pragma unroll
            for (int j = 0; j < 8; ++j) *(f32x4*)(dstF + (size_t)row * D + 4 * lane + 256 * j) = v[j];
        }
        if (dstB) {
#pragma unroll
            for (int j = 0; j < 8; ++j) { u32x2 w; w.x = pk(v[j].x, v[j].y); w.y = pk(v[j].z, v[j].w); *(u32x2*)(dstB + (size_t)row * D + 4 * lane + 256 * j) = w; }
        }
        if (ZERO_SRC) {
#pragma unroll
            for (int j = 0; j < 8; ++j) *(f32x4*)((float*)src + (size_t)row * D + 4 * lane + 256 * j) = (f32x4){0.f, 0.f, 0.f, 0.f};
        }
        if (GATES) {
            float mine = 0.f;
#pragma unroll 1
            for (int jj = 0; jj < 16; ++jj) {
                float a = 0.f;
#pragma unroll
                for (int j = 0; j < 8; ++j) { const f32x4 w = *(const f32x4*)(Wg + jj * D + 4 * lane + 256 * j); a += (v[j].x * w.x + v[j].y * w.y) + (v[j].z * w.z + v[j].w * w.w); }
                a = wave_sum(a); if (lane == jj) mine = a;
            }
            if (lane < 16) G[(size_t)row * 16 + lane] = mine;
        }
    }
}
#define MFMA16(a, b, c) __builtin_amdgcn_mfma_f32_16x16x32_bf16(a, b, c, 0, 0, 0)
#define LBAR() do { asm volatile("s_waitcnt lgkmcnt(0)" ::: "memory"); __builtin_amdgcn_s_barrier(); asm volatile("" ::: "memory"); } while (0)
#define TMAP(i) (dir ? (T - 1 - (i)) : (i))
__device__ __forceinline__ bf16x8 frag(const LAS bf16* base, int row, int stride, int koff) { return *(const LAS bf16x8*)(base + row * stride + koff); }
__device__ __forceinline__ bf16x8 frag_kt(const LAS bf16* base, int row, int chunk) { return *(const LAS bf16x8*)(base + row * 72 + ((chunk ^ ((row >> 1) & 7)) << 3)); }
__device__ __forceinline__ u32x2 pk4(f32x4 v) { u32x2 w; w.x = pk_c(v[0], v[1]); w.y = pk_c(v[2], v[3]); return w; }

__device__ __forceinline__ void hgrn_pre(LAS unsigned char* lds, bf16* Z, const float* hgrn_lb, bf16* AB, float* DEC, int item) {
    const int tid = threadIdx.x, lane = tid & 63, w = __builtin_amdgcn_readfirstlane(tid >> 6);
    const int h = item & 7, c = (item >> 3) & 63, b = item >> 9;
    LAS float* sF = (LAS float*)lds;
    LAS float* sR = sF + 1024;
    const int c0 = 2 * lane;
    float lbf0, lbf1, lbb0, lbb1;
    { const float* lp = hgrn_lb + h * 128 + c0; lbf0 = 1.f / (1.f + expf(lp[1024] - lp[0])); lbf1 = 1.f / (1.f + expf(lp[1025] - lp[1]));
      lbb0 = 1.f / (1.f + expf(lp[2048 + 1024] - lp[2048])); lbb1 = 1.f / (1.f + expf(lp[2048 + 1025] - lp[2049])); }
    bf16* zr = Z + ((size_t)b * T + c * 64 + 8 * w) * ZC + h * 128 + c0;
    unsigned rq[8], rf[8], rb[8];
#pragma unroll
    for (int j = 0; j < 8; ++j) { rq[j] = __builtin_nontemporal_load((const unsigned*)(zr + (size_t)j * ZC)); rf[j] = __builtin_nontemporal_load((const unsigned*)(zr + (size_t)j * ZC + 3072)); rb[j] = __builtin_nontemporal_load((const unsigned*)(zr + (size_t)j * ZC + 4096)); }
    float kf0[8], kf1[8], kb0[8], kb1[8], pf0[8], pf1[8], pb0[8], pb1[8];
    float runf0 = 0.f, runf1 = 0.f;
#pragma unroll
    for (int j = 0; j < 8; ++j) { const float f0 = lbf0 + (1.f - lbf0) * sigm(bflo(rf[j])), f1 = lbf1 + (1.f - lbf1) * sigm(bfhi(rf[j]));
        runf0 += __logf(f0); runf1 += __logf(f1); pf0[j] = runf0; pf1[j] = runf1; kf0[j] = 1.f - f0; kf1[j] = 1.f - f1; }
    float runb0 = 0.f, runb1 = 0.f;
#pragma unroll
    for (int j = 7; j >= 0; --j) { const float f0 = lbb0 + (1.f - lbb0) * sigm(bflo(rb[j])), f1 = lbb1 + (1.f - lbb1) * sigm(bfhi(rb[j]));
        runb0 += __logf(f0); runb1 += __logf(f1); pb0[j] = runb0; pb1[j] = runb1; kb0[j] = 1.f - f0; kb1[j] = 1.f - f1; }
    sF[w * 128 + c0] = runf0; sF[w * 128 + c0 + 1] = runf1; sR[w * 128 + c0] = runb0; sR[w * 128 + c0 + 1] = runb1;
    LBAR();
    float of0 = 0.f, of1 = 0.f, tf0 = 0.f, tf1 = 0.f, ob0 = 0.f, ob1 = 0.f, tb0 = 0.f, tb1 = 0.f;
#pragma unroll
    for (int ww = 0; ww < 8; ++ww) { const float a0 = sF[ww * 128 + c0], a1 = sF[ww * 128 + c0 + 1], d0 = sR[ww * 128 + c0], d1 = sR[ww * 128 + c0 + 1];
        tf0 += a0; tf1 += a1; tb0 += d0; tb1 += d1; if (ww < w) { of0 += a0; of1 += a1; } if (ww > w) { ob0 += d0; ob1 += d1; } }
    bf16* ar = AB + ((size_t)b * T + c * 64 + 8 * w) * 1024 + h * 128 + c0;
#pragma unroll
    for (int j = 0; j < 8; ++j) {
        const float q0 = silu(bflo(rq[j])) * 0.08838834764831845f, q1 = silu(bfhi(rq[j])) * 0.08838834764831845f;
        const float ef0 = of0 + pf0[j] - tf0, ef1 = of1 + pf1[j] - tf1, eb0 = ob0 + pb0[j] - tb0, eb1 = ob1 + pb1[j] - tb1;
        *(unsigned*)(zr + (size_t)j * ZC) = pk_c(q0 * __expf(fminf(ef0, 80.f)), q1 * __expf(fminf(ef1, 80.f)));
        *(unsigned*)(ar + (size_t)j * 1024) = pk_c(q0 * __expf(fminf(eb0, 80.f)), q1 * __expf(fminf(eb1, 80.f)));
        *(unsigned*)(zr + (size_t)j * ZC + 3072) = pk_c(kf0[j] * __expf(-ef0), kf1[j] * __expf(-ef1));
        *(unsigned*)(zr + (size_t)j * ZC + 4096) = pk_c(kb0[j] * __expf(-eb0), kb1[j] * __expf(-eb1));
    }
    if (w == 0) { float* dp = DEC + ((size_t)(b * 2) * 64 + c) * 1024 + h * 128 + c0; dp[0] = __expf(tf0); dp[1] = __expf(tf1); dp[64 * 1024] = __expf(tb0); dp[64 * 1024 + 1] = __expf(tb1); }
    LBAR();
}
__device__ __forceinline__ void mlstm_pre(LAS unsigned char* lds, const bf16* Z, const bf16* XBF, const float* Wg, float* G, const float* conv_w, const float* conv_b, const float* ig_b, const float* fg_b, bf16* QK, bf16* PS, int item) {
    const int tid = threadIdx.x, lane = tid & 63, w = __builtin_amdgcn_readfirstlane(tid >> 6), r = lane & 15, q = lane >> 4;
    const int h = item & 3, c = (item >> 2) & 63, b = item >> 8;
    LAS bf16* sQ = (LAS bf16*)lds;
    LAS bf16* sK = sQ + 64 * 264;
    const int seg = w >> 1, cp = (w & 1) * 64 + lane, c0 = 2 * cp;
    LAS float* sGt = (LAS float*)(lds + 2 * 64 * 264 * 2);
    {
      f32x4 wv[4][8];
#pragma unroll
      for (int g = 0; g < 4; ++g)
#pragma unroll
        for (int j = 0; j < 8; ++j) wv[g][j] = *(const f32x4*)(Wg + (size_t)(4 * g + h) * D + 512 * (j >> 1) + 8 * lane + 4 * (j & 1));
#pragma unroll 1
      for (int rr = 0; rr < 8; ++rr) {
        const size_t row = (size_t)b * T + c * 64 + 8 * w + rr; const bf16* xr = XBF + row * D + 8 * lane; float a[4] = {0.f, 0.f, 0.f, 0.f};
#pragma unroll
        for (int j = 0; j < 4; ++j) { const u32x4 xb = *(const u32x4*)(xr + 512 * j);
            const f32x4 x0 = {bflo(xb.x), bfhi(xb.x), bflo(xb.y), bfhi(xb.y)}, x1 = {bflo(xb.z), bfhi(xb.z), bflo(xb.w), bfhi(xb.w)};
#pragma unroll
            for (int g = 0; g < 4; ++g) a[g] += ((x0.x * wv[g][2 * j].x + x0.y * wv[g][2 * j].y) + (x0.z * wv[g][2 * j].z + x0.w * wv[g][2 * j].w))
                                              + ((x1.x * wv[g][2 * j + 1].x + x1.y * wv[g][2 * j + 1].y) + (x1.z * wv[g][2 * j + 1].z + x1.w * wv[g][2 * j + 1].w)); }
#pragma unroll
        for (int o = 1; o < 64; o <<= 1) {
#pragma unroll
            for (int g = 0; g < 4; ++g) a[g] += __shfl_xor(a[g], o); }
        if (lane == 0) *(LAS f32x4*)(sGt + (8 * w + rr) * 4) = (f32x4){a[0], a[1], a[2], a[3]};
      } }
    LBAR();
    float wq0[5], wq1[5], wk0[5], wk1[5];
#pragma unroll
    for (int j = 0; j < 5; ++j) { const float* cw = conv_w + j * 2048 + h * 256 + c0; wq0[j] = cw[0]; wq1[j] = cw[1]; wk0[j] = cw[1024]; wk1[j] = cw[1025]; }
    const float bq0 = conv_b[h * 256 + c0], bq1 = conv_b[h * 256 + c0 + 1], bk0 = conv_b[1024 + h * 256 + c0], bk1 = conv_b[1024 + h * 256 + c0 + 1];
    const bf16* zq = Z + (size_t)b * T * ZC + 5120 + h * 256;
    const bf16* zk = Z + (size_t)b * T * ZC + 6144 + h * 256;
    unsigned xq[20], xk[20];
#pragma unroll
    for (int m = 0; m < 20; ++m) { const int t = c * 64 + 16 * seg - 2 + m; const bool ok = (t >= 0) && (t < T); const size_t tt = (size_t)(ok ? t : 0);
        const unsigned a = __builtin_nontemporal_load((const unsigned*)(zq + tt * ZC + c0)), d = __builtin_nontemporal_load((const unsigned*)(zk + tt * ZC + c0)); xq[m] = ok ? a : 0u; xk[m] = ok ? d : 0u; }
    float igF, igB, bcF, bcB;
    { const f32x4 gl = *(const LAS f32x4*)(sGt + lane * 4);
      igF = gl.x + ig_b[h]; igB = gl.y + ig_b[4 + h];
      const float mfF = gl.z + fg_b[h], mfB = gl.w + fg_b[4 + h];
      bcF = mfF >= 0.f ? -log1pf(expf(-mfF)) : mfF - log1pf(expf(mfF));
      bcB = mfB >= 0.f ? -log1pf(expf(-mfB)) : mfB - log1pf(expf(mfB));
#pragma unroll
      for (int o = 1; o < 64; o <<= 1) { const float u = __shfl_up(bcF, o), v = __shfl_down(bcB, o); if (lane >= o) bcF += u; if (lane + o < 64) bcB += v; } }
    const float blF = __shfl(bcF, 63), blB = __shfl(bcB, 0);
    if (w == 0) { float* go = G + ((size_t)b * T + c * 64 + lane) * 16 + h; go[0] = __expf(blF - bcF + igF); go[4] = __expf(blB - bcB + igB); go[8] = __expf(bcF); go[12] = __expf(bcB); }
    bf16* orow = QK + ((size_t)b * T + c * 64 + 16 * seg) * 2048 + h * 256 + c0;
#pragma unroll
    for (int il = 0; il < 16; ++il) {
        float aq0 = bq0, aq1 = bq1, ak0 = bk0, ak1 = bk1;
#pragma unroll
        for (int j = 0; j < 5; ++j) { aq0 += wq0[j] * bflo(xq[il + j]); aq1 += wq1[j] * bfhi(xq[il + j]); ak0 += wk0[j] * bflo(xk[il + j]); ak1 += wk1[j] * bfhi(xk[il + j]); }
        const unsigned qv = pk_c(silu(aq0) * 0.0625f, silu(aq1) * 0.0625f), kv = pk_c(silu(ak0), silu(ak1));
        *(unsigned*)(orow + (size_t)il * 2048) = qv; *(unsigned*)(orow + (size_t)il * 2048 + 1024) = kv;
        *(LAS unsigned*)(sQ + (16 * seg + il) * 264 + c0) = qv; *(LAS unsigned*)(sK + (16 * seg + il) * 264 + c0) = kv;
    }
    LBAR();
    const int ti = w >> 1;
    bf16* pf = PS + ((size_t)((b * 4 + h) * 64 + c) * 2) * 4096; bf16* pb = pf + 4096;
#pragma unroll
    for (int jj = 0; jj < 2; ++jj) {
        const int sj = (w & 1) * 2 + jj;
        f32x4 acc = {0.f, 0.f, 0.f, 0.f};
#pragma unroll
        for (int kk = 0; kk < 8; ++kk) acc = MFMA16(frag(sK, 16 * sj + r, 264, 32 * kk + 8 * q), frag(sQ, 16 * ti + r, 264, 32 * kk + 8 * q), acc);
        const int t = 16 * ti + r, s0 = 16 * sj + 4 * q;
        const float eF = __expf(__shfl(bcF, t) - blF), eB = __expf(__shfl(bcB, t) - blB);
        f32x4 vf, vb;
#pragma unroll
        for (int i = 0; i < 4; ++i) { const int sx = s0 + i; vf[i] = (sx <= t) ? acc[i] * eF : 0.f; vb[3 - i] = (sx >= t) ? acc[i] * eB : 0.f; }
        *(u32x2*)(pf + t * 64 + s0) = pk4(vf);
        *(u32x2*)(pb + (63 - t) * 64 + (60 - s0)) = pk4(vb);
    }
    LBAR();
}

__device__ __forceinline__ void hgrn_scan(LAS unsigned char* lds, const bf16* Z, const bf16* AB, const float* DEC, float* O, bf16* OB, int item) {
    const int tid = threadIdx.x, lane = tid & 63, w = __builtin_amdgcn_readfirstlane(tid >> 6), r = lane & 15, q = lane >> 4;
    const int sl = item & 3, dir = (item >> 2) & 1, h = (item >> 3) & 7, b = item >> 6;
    constexpr int HSET = 2 * 64 * 136 + 128 * 72 + 32 * 72;
    LAS bf16* sA0 = (LAS bf16*)lds;
    LAS bf16* sP = sA0 + 2 * HSET;
    LAS bf16* sST = sP + 64 * 72;
    for (int i = tid; i < 32 * 136 / 2; i += 512) ((LAS unsigned*)sST)[i] = 0u;
    LBAR();
    const int c0 = 2 * lane;
    const bf16* za = dir ? AB + (size_t)b * T * 1024 + h * 128 : Z + (size_t)b * T * ZC + h * 128;
    const size_t lda = dir ? 1024 : ZC;
    const bf16* zk = Z + (size_t)b * T * ZC + 3072 + dir * 1024 + h * 128;
    const int vp = lane & 15, vseg = (w & 1) * 4 + (lane >> 4);
    const bf16* zv = Z + (size_t)b * T * ZC + 1024 + h * 128 + sl * 32;
    const float* decp = DEC + ((size_t)(b * 2 + dir) * 64) * 1024 + h * 128 + 16 * w + 4 * q;
    const size_t obase = (size_t)b * T * D + h * 128 + sl * 32;
    f32x4 Sacc[2] = {{0.f, 0.f, 0.f, 0.f}, {0.f, 0.f, 0.f, 0.f}};
    unsigned ra[8], rk[8], rv[8]; f32x4 dcur, dnxt;
#define HG_LOAD(ci_) do { _Pragma("unroll") for (int j = 0; j < 8; ++j) { const size_t t_ = (size_t)TMAP((ci_) * 64 + 8 * w + j); ra[j] = *(const unsigned*)(za + t_ * lda + c0); rk[j] = *(const unsigned*)(zk + t_ * ZC + c0); } \
        if (w < 2) { _Pragma("unroll") for (int j = 0; j < 8; ++j) rv[j] = __builtin_nontemporal_load((const unsigned*)(zv + (size_t)TMAP((ci_) * 64 + 8 * vseg + j) * ZC + 2 * vp)); } } while (0)
#define HG_DEC(ci_) (*(const f32x4*)(decp + (size_t)(dir ? 63 - (ci_) : (ci_)) * 1024))
    HG_LOAD(0); dcur = HG_DEC(0);
    const int ti = w >> 1, ej = w & 1;
    for (int ci = 0; ci < 64; ++ci) {
        LAS bf16* sA = sA0 + (ci & 1) * HSET;
        LAS bf16* sB = sA + 64 * 136;
        LAS bf16* sKd = sB + 64 * 136;
        LAS bf16* sVT = sKd + 128 * 72;
#pragma unroll
        for (int j = 0; j < 8; ++j) { const int i = 8 * w + j; *(LAS unsigned*)(sA + i * 136 + c0) = ra[j]; *(LAS unsigned*)(sB + i * 136 + c0) = rk[j]; }
        { u32x4 a, c;
          a.x = (rk[0] & 0xffffu) | (rk[1] << 16); a.y = (rk[2] & 0xffffu) | (rk[3] << 16); a.z = (rk[4] & 0xffffu) | (rk[5] << 16); a.w = (rk[6] & 0xffffu) | (rk[7] << 16);
          c.x = (rk[0] >> 16) | (rk[1] & 0xffff0000u); c.y = (rk[2] >> 16) | (rk[3] & 0xffff0000u); c.z = (rk[4] >> 16) | (rk[5] & 0xffff0000u); c.w = (rk[6] >> 16) | (rk[7] & 0xffff0000u);
          const int cs = (w ^ (lane & 7)) << 3; *(LAS u32x4*)(sKd + c0 * 72 + cs) = a; *(LAS u32x4*)(sKd + (c0 + 1) * 72 + cs) = c; }
        if (w < 2) { u32x4 a, c; const int cs = (vseg ^ (vp & 7)) << 3;
          a.x = (rv[0] & 0xffffu) | (rv[1] << 16); a.y = (rv[2] & 0xffffu) | (rv[3] << 16); a.z = (rv[4] & 0xffffu) | (rv[5] << 16); a.w = (rv[6] & 0xffffu) | (rv[7] << 16);
          c.x = (rv[0] >> 16) | (rv[1] & 0xffff0000u); c.y = (rv[2] >> 16) | (rv[3] & 0xffff0000u); c.z = (rv[4] >> 16) | (rv[5] & 0xffff0000u); c.w = (rv[6] >> 16) | (rv[7] & 0xffff0000u);
          *(LAS u32x4*)(sVT + (2 * vp) * 72 + cs) = a; *(LAS u32x4*)(sVT + (2 * vp + 1) * 72 + cs) = c; }
        LBAR();
        if (ci + 1 < 64) { HG_LOAD(ci + 1); dnxt = HG_DEC(ci + 1); } else dnxt = dcur;
#pragma unroll
        for (int jj = 0; jj < 2; ++jj) {
            const int sj = (w & 1) * 2 + jj; u32x2 pw; pw.x = 0u; pw.y = 0u;
            if (sj <= ti) {
                f32x4 acc = {0.f, 0.f, 0.f, 0.f};
#pragma unroll
                for (int kk = 0; kk < 4; ++kk) acc = MFMA16(frag(sB, 16 * sj + r, 136, 32 * kk + 8 * q), frag(sA, 16 * ti + r, 136, 32 * kk + 8 * q), acc);
                const int t = 16 * ti + r, s0 = 16 * sj + 4 * q;
#pragma unroll
                for (int i = 0; i < 4; ++i) acc[i] = (s0 + i <= t) ? acc[i] : 0.f;
                pw = pk4(acc);
            }
            *(LAS u32x2*)(sP + (16 * ti + r) * 72 + 16 * sj + 4 * q) = pw;
        }
        f32x4 o = {0.f, 0.f, 0.f, 0.f};
#pragma unroll
        for (int kk = 0; kk < 4; ++kk) o = MFMA16(frag(sA, 16 * ti + r, 136, 32 * kk + 8 * q), frag(sST, 16 * ej + r, 136, 32 * kk + 8 * q), o);
        LBAR();
#pragma unroll
        for (int kk = 0; kk < 2; ++kk) o = MFMA16(frag(sP, 16 * ti + r, 72, 32 * kk + 8 * q), frag_kt(sVT, 16 * ej + r, 4 * kk + q), o);
#pragma unroll
        for (int i = 0; i < 4; ++i) { const size_t t = (size_t)TMAP(ci * 64 + 16 * ti + 4 * q + i); const size_t oi = obase + t * D + 16 * ej + r; (dir ? OB : (bf16*)O)[oi] = (bf16)(pk_c(o[i], 0.f) & 0xffffu); }
#pragma unroll
        for (int e2 = 0; e2 < 2; ++e2) {
            Sacc[e2] = Sacc[e2] * dcur;
#pragma unroll
            for (int kk = 0; kk < 2; ++kk) Sacc[e2] = MFMA16(frag_kt(sKd, 16 * w + r, 4 * kk + q), frag_kt(sVT, 16 * e2 + r, 4 * kk + q), Sacc[e2]);
            *(LAS u32x2*)(sST + (16 * e2 + r) * 136 + 16 * w + 4 * q) = pk4(Sacc[e2] * dnxt);
        }
        dcur = dnxt;
    }
    LBAR();
#undef HG_LOAD
#undef HG_DEC
}

__device__ __forceinline__ void mlstm_scan(LAS unsigned char* lds, const bf16* Z, const float* G, const float* conv_w, const float* conv_b, const float* ig_b, const float* fg_b, float* O, bf16* OB, const bf16* QK, const bf16* PS, int item) {
    const int tid = threadIdx.x, lane = tid & 63, w = __builtin_amdgcn_readfirstlane(tid >> 6), r = lane & 15, q = lane >> 4;
    const int sl = item & 7, dir = (item >> 3) & 1, h = (item >> 4) & 3, b = item >> 6;
    LAS bf16* sQ = (LAS bf16*)lds;
    LAS bf16* sKT = sQ + 64 * 264;
    LAS bf16* sVT = sKT + 256 * 72;
    LAS bf16* sVw = sVT + 34 * 72;
    LAS bf16* sP = sVw + 34 * 72;
    LAS bf16* sCT0 = sP + 64 * 72;
    for (int i = tid; i < 2 * 34 * 264 / 2; i += 512) ((LAS unsigned*)sCT0)[i] = 0u;
    for (int i = tid; i < 2 * 34 * 72 / 2; i += 512) ((LAS unsigned*)sVT)[i] = 0u;
    LBAR();
    const int r2 = 32 + (r ? 1 : 0);
    const int seg = w >> 1, cp = (w & 1) * 64 + lane, c0 = 2 * cp;
    const bf16* zq = QK + (size_t)b * T * 2048 + h * 256;
    const bf16* zk = zq + 1024;
    const bf16* pp = PS + ((size_t)((b * 4 + h) * 64) * 2 + dir) * 4096 + tid * 8;
    const int vp = lane & 15, vseg = (w & 1) * 4 + (lane >> 4);
    const bf16* zv = Z + (size_t)b * T * ZC + 7168 + h * 256 + sl * 32;
    const float* gp = G + (size_t)b * T * 16 + dir * 4 + h;
    const float igb = ig_b[dir * 4 + h], fgb = fg_b[dir * 4 + h];
    const size_t obase = (size_t)b * T * D + 1024 + h * 256 + sl * 32;
    f32x4 Cacc[2][3];
#pragma unroll
    for (int a = 0; a < 2; ++a)
#pragma unroll
        for (int c = 0; c < 3; ++c) Cacc[a][c] = (f32x4){0.f, 0.f, 0.f, 0.f};
    unsigned xq[2][16], xk[2][16], rv[8]; u32x4 rp; float gws, gbc, wsv[8];
#define ML_LOAD(ci_, S_) do { _Pragma("unroll") for (int m = 0; m < 16; ++m) { const size_t t_ = (size_t)TMAP((ci_) * 64 + 16 * seg + m); xq[S_][m] = *(const unsigned*)(zq + t_ * 2048 + c0); xk[S_][m] = *(const unsigned*)(zk + t_ * 2048 + c0); } } while (0)
#define ML_LOAD2(ci_) do { if (w < 2) { _Pragma("unroll") for (int j = 0; j < 8; ++j) { const size_t t_ = (size_t)TMAP((ci_) * 64 + 8 * vseg + j); rv[j] = __builtin_nontemporal_load((const unsigned*)(zv + t_ * ZC + 2 * vp)); wsv[j] = gp[t_ * 16]; } } \
        rp = *(const u32x4*)(pp + (size_t)(dir ? 63 - (ci_) : (ci_)) * 8192); \
        { const size_t t_ = (size_t)TMAP((ci_) * 64 + lane); gws = gp[t_ * 16]; gbc = gp[t_ * 16 + 8]; } } while (0)
    ML_LOAD(0, 0); ML_LOAD2(0); ML_LOAD(1, 1);
    const int ti = w >> 1, ej = w & 1;
    for (int cc = 0; cc < 64; cc += 2) {
#pragma unroll
      for (int half = 0; half < 2; ++half) {
        const int ci = cc + half;
        const LAS bf16* sCT = sCT0 + half * (34 * 264); LAS bf16* sCTn = sCT0 + (half ^ 1) * (34 * 264);
        const float bc = gbc;
        const float dec = __shfl(bc, 63);
        if (w == 0) { sVw[32 * 72 + lane] = (bf16)(pk_c(gws, 0.f) & 0xffffu); }
#pragma unroll
        for (int m = 0; m < 16; ++m) *(LAS unsigned*)(sQ + (16 * seg + m) * 264 + c0) = xq[half][m];
        *(LAS u32x4*)(sP + (tid >> 3) * 72 + (tid & 7) * 8) = rp;
#pragma unroll
        for (int u = 0; u < 2; ++u) { u32x4 a, c; const int cs = ((2 * seg + u) ^ (lane & 7)) << 3;
            a.x = (xk[half][8 * u + 0] & 0xffffu) | (xk[half][8 * u + 1] << 16); a.y = (xk[half][8 * u + 2] & 0xffffu) | (xk[half][8 * u + 3] << 16); a.z = (xk[half][8 * u + 4] & 0xffffu) | (xk[half][8 * u + 5] << 16); a.w = (xk[half][8 * u + 6] & 0xffffu) | (xk[half][8 * u + 7] << 16);
            c.x = (xk[half][8 * u + 0] >> 16) | (xk[half][8 * u + 1] & 0xffff0000u); c.y = (xk[half][8 * u + 2] >> 16) | (xk[half][8 * u + 3] & 0xffff0000u); c.z = (xk[half][8 * u + 4] >> 16) | (xk[half][8 * u + 5] & 0xffff0000u); c.w = (xk[half][8 * u + 6] >> 16) | (xk[half][8 * u + 7] & 0xffff0000u);
            *(LAS u32x4*)(sKT + c0 * 72 + cs) = a; *(LAS u32x4*)(sKT + (c0 + 1) * 72 + cs) = c; }
        if (w < 2) { u32x4 aw, cw; const int cs = (vseg ^ (vp & 7)) << 3;
          aw.x = pk(bflo(rv[0]) * wsv[0], bflo(rv[1]) * wsv[1]); aw.y = pk(bflo(rv[2]) * wsv[2], bflo(rv[3]) * wsv[3]); aw.z = pk(bflo(rv[4]) * wsv[4], bflo(rv[5]) * wsv[5]); aw.w = pk(bflo(rv[6]) * wsv[6], bflo(rv[7]) * wsv[7]);
          cw.x = pk(bfhi(rv[0]) * wsv[0], bfhi(rv[1]) * wsv[1]); cw.y = pk(bfhi(rv[2]) * wsv[2], bfhi(rv[3]) * wsv[3]); cw.z = pk(bfhi(rv[4]) * wsv[4], bfhi(rv[5]) * wsv[5]); cw.w = pk(bfhi(rv[6]) * wsv[6], bfhi(rv[7]) * wsv[7]);
          *(LAS u32x4*)(sVw + (2 * vp) * 72 + cs) = aw; *(LAS u32x4*)(sVw + (2 * vp + 1) * 72 + cs) = cw; }
        LBAR();
        if (ci + 2 < 64) ML_LOAD(ci + 2, half);
        if (ci + 1 < 64) ML_LOAD2(ci + 1);
        __builtin_amdgcn_sched_barrier(0);
        f32x4 o1 = {0.f, 0.f, 0.f, 0.f}, o2 = {0.f, 0.f, 0.f, 0.f};
#pragma unroll
        for (int kk = 0; kk < 8; ++kk) { const bf16x8 a = frag(sQ, 16 * ti + r, 264, 32 * kk + 8 * q);
            o1 = MFMA16(a, frag(sCT, 16 * ej + r, 264, 32 * kk + 8 * q), o1); o2 = MFMA16(a, frag(sCT, r2, 264, 32 * kk + 8 * q), o2);
            if (kk & 1) __builtin_amdgcn_sched_barrier(0); }
#pragma unroll
        for (int i = 0; i < 4; ++i) { const float e = __shfl(bc, 16 * ti + 4 * q + i); o1[i] *= e; o2[i] *= e; }
#pragma unroll
        for (int kk = 0; kk < 2; ++kk) { const bf16x8 a = frag(sP, 16 * ti + r, 72, 32 * kk + 8 * q);
            o1 = MFMA16(a, frag_kt(sVw, 16 * ej + r, 4 * kk + q), o1); o2 = MFMA16(a, frag_kt(sVw, r2, 4 * kk + q), o2); }
#pragma unroll
        for (int i = 0; i < 4; ++i) { const float dn = __shfl(o2[i], lane & 48); const size_t t = (size_t)TMAP(ci * 64 + 16 * ti + 4 * q + i);
            const float hv = o1[i] * __builtin_amdgcn_rcpf(fmaxf(fabsf(dn), 1.f)); const size_t oi = obase + t * D + 16 * ej + r; (dir ? OB : (bf16*)O)[oi] = (bf16)(pk_c(hv, 0.f) & 0xffffu); }
#pragma unroll
        for (int dt = 0; dt < 2; ++dt)
#pragma unroll
            for (int et = 0; et < 3; ++et) {
                Cacc[dt][et] = Cacc[dt][et] * dec;
#pragma unroll
                for (int kk = 0; kk < 2; ++kk) Cacc[dt][et] = MFMA16(frag_kt(sKT, 16 * (2 * w + dt) + r, 4 * kk + q), frag_kt(sVw, et < 2 ? 16 * et + r : r2, 4 * kk + q), Cacc[dt][et]);
                if (et < 2 || r == 0) *(LAS u32x2*)(sCTn + (16 * et + r) * 264 + 16 * (2 * w + dt) + 4 * q) = pk4(Cacc[dt][et]);
            }
        LBAR();
      }
    }
#undef ML_LOAD
#undef ML_LOAD2
}
__device__ __forceinline__ void finalize_phase(const bf16* O, const bf16* OB, const bf16* Z, const float* hg_g, const float* ml_g, bf16* Y, int gw, int NGW, int lane) {
    for (int row = gw; row < M; row += NGW) {
        u32x4 oa4[4], ob4[4], gz4[4];
#pragma unroll
        for (int jc = 0; jc < 4; ++jc) { const int col = 512 * jc + 8 * lane;
            oa4[jc] = __builtin_nontemporal_load((const u32x4*)(O + (size_t)row * D + col)); ob4[jc] = __builtin_nontemporal_load((const u32x4*)(OB + (size_t)row * D + col));
            gz4[jc] = __builtin_nontemporal_load((const u32x4*)(Z + (size_t)row * ZC + (jc < 2 ? 2048 + col : 8192 + col - 1024))); }
#pragma unroll
        for (int jc = 0; jc < 4; ++jc) {
            const int col = 512 * jc + 8 * lane;
            const u32x4 oa = oa4[jc], ob = ob4[jc];
            const f32x4 a = {bflo(oa.x), bfhi(oa.x), bflo(oa.y), bfhi(oa.y)}, c = {bflo(oa.z), bfhi(oa.z), bflo(oa.w), bfhi(oa.w)};
            float o[8] = {a.x + bflo(ob.x), a.y + bfhi(ob.x), a.z + bflo(ob.y), a.w + bfhi(ob.y), c.x + bflo(ob.z), c.y + bfhi(ob.z), c.z + bflo(ob.w), c.w + bfhi(ob.w)};
            const u32x4 gz = gz4[jc];
            const float gt[8] = {bflo(gz.x), bfhi(gz.x), bflo(gz.y), bfhi(gz.y), bflo(gz.z), bfhi(gz.z), bflo(gz.w), bfhi(gz.w)};
            const float* gp = jc < 2 ? hg_g + col : ml_g + col - 1024;
            const f32x4 g0 = *(const f32x4*)gp, g1 = *(const f32x4*)(gp + 4);
            const float gg[8] = {g0.x, g0.y, g0.z, g0.w, g1.x, g1.y, g1.z, g1.w};
            float y[8];
            if (jc < 2) {
                float ss = 0.f;
#pragma unroll
                for (int j = 0; j < 8; ++j) ss += o[j] * o[j];
                ss += __shfl_xor(ss, 1); ss += __shfl_xor(ss, 2); ss += __shfl_xor(ss, 4); ss += __shfl_xor(ss, 8);
                const float rs = 1.0f / sqrtf(ss * (1.f / 128.f) + 1e-6f);
#pragma unroll
                for (int j = 0; j < 8; ++j) y[j] = o[j] * rs * gg[j] * silu(gt[j]);
            } else {
                float s = 0.f;
#pragma unroll
                for (int j = 0; j < 8; ++j) s += o[j];
                s += __shfl_xor(s, 1); s += __shfl_xor(s, 2); s += __shfl_xor(s, 4); s += __shfl_xor(s, 8); s += __shfl_xor(s, 16);
                const float mu = s * (1.f / 256.f); float ss = 0.f;
#pragma unroll
                for (int j = 0; j < 8; ++j) { o[j] -= mu; ss += o[j] * o[j]; }
                ss += __shfl_xor(ss, 1); ss += __shfl_xor(ss, 2); ss += __shfl_xor(ss, 4); ss += __shfl_xor(ss, 8); ss += __shfl_xor(ss, 16);
                const float rs = 1.0f / sqrtf(ss * (1.f / 256.f) + 1e-6f);
#pragma unroll
                for (int j = 0; j < 8; ++j) y[j] = o[j] * rs * gg[j] * sigm(gt[j]);
            }
            u32x4 w; w.x = pk(y[0], y[1]); w.y = pk(y[2], y[3]); w.z = pk(y[4], y[5]); w.w = pk(y[6], y[7]);
            *(u32x4*)(Y + (size_t)row * D + col) = w;
        }
    }
}

#define GB_CENSUS(j) (64 * (j))
#define GB_ARR(j) (1024 + 64 * (j))
#define GB_GEN(j) (2048 + 64 * (j))
#define GB_TOP 3072
#define GB_TOPGEN 3136
#define GB_WORDS 3200
__device__ __forceinline__ unsigned gb_ld(unsigned* p) { return __hip_atomic_load(p, __ATOMIC_RELAXED, __HIP_MEMORY_SCOPE_AGENT); }
__device__ __forceinline__ unsigned gb_xcc() { return (unsigned)__builtin_amdgcn_s_getreg((3 << 11) | 20) & 0xFu; }
__device__ __forceinline__ void grid_bar(unsigned* bw, unsigned k, volatile LAS unsigned* cen) {
    asm volatile("s_waitcnt vmcnt(0) lgkmcnt(0)" ::: "memory");
    __syncthreads();
    if (threadIdx.x == 0) {
        const unsigned x = gb_xcc(), nloc = cen[0], nx = cen[1];
        const unsigned old = __hip_atomic_fetch_add(bw + GB_ARR(x), 1u, __ATOMIC_RELAXED, __HIP_MEMORY_SCOPE_AGENT);
        if (old + 1u == k * nloc) {
            __builtin_amdgcn_fence(__ATOMIC_RELEASE, "agent");
            asm volatile("s_waitcnt vmcnt(0)" ::: "memory");
            const unsigned oldt = __hip_atomic_fetch_add(bw + GB_TOP, 1u, __ATOMIC_RELAXED, __HIP_MEMORY_SCOPE_AGENT);
            if (oldt + 1u == k * nx) __hip_atomic_store(bw + GB_TOPGEN, k, __ATOMIC_RELAXED, __HIP_MEMORY_SCOPE_AGENT);
            else while (gb_ld(bw + GB_TOPGEN) < k) __builtin_amdgcn_s_sleep(1);
            __hip_atomic_store(bw + GB_GEN(x), k, __ATOMIC_RELAXED, __HIP_MEMORY_SCOPE_AGENT);
        } else while (gb_ld(bw + GB_GEN(x)) < k) __builtin_amdgcn_s_sleep(1);
        __builtin_amdgcn_fence(__ATOMIC_ACQUIRE, "agent");
        asm volatile("s_waitcnt vmcnt(0)" ::: "memory");
    }
    __syncthreads();
}
#ifndef REP_SCAN
#define REP_SCAN 1
#endif
#ifndef REP_GEMM
#define REP_GEMM 1
#endif
struct Args { const float* in[22]; float* out; unsigned char* ws; int ph_lo, ph_hi; };
constexpr int NPH = 12;
__global__ void __launch_bounds__(512, 2) mk_fwd(Args a) {
    extern __shared__ __attribute__((aligned(16))) unsigned char lds_raw[];
    LAS unsigned char* lds = (LAS unsigned char*)lds_raw;
    cg::grid_group grid = cg::this_grid();
    const int tid = threadIdx.x, lane = tid & 63, wave = __builtin_amdgcn_readfirstlane(tid >> 6);
    const int G_ = gridDim.x, bx = blockIdx.x, vcu = (G_ % 8 == 0) ? (bx % 8) * (G_ / 8) + bx / 8 : bx;
    const int gw = vcu * 8 + wave, NGW = G_ * 8;
    const float* x = a.in[0];
    const float *f1w1 = a.in[1], *f1w3 = a.in[2], *f1w2 = a.in[3], *ln1g = a.in[4], *ln1b = a.in[5], *w_in = a.in[6], *hgrn_lb = a.in[7], *hgrn_g = a.in[8],
                *conv_w = a.in[9], *conv_b = a.in[10], *ig_b = a.in[11], *fg_b = a.in[12], *ml_g = a.in[13], *w_out = a.in[14], *ln2g = a.in[15], *ln2b = a.in[16],
                *f2w1 = a.in[17], *f2w3 = a.in[18], *f2w2 = a.in[19], *ln3g = a.in[20], *ln3b = a.in[21];
    unsigned char* ws = a.ws; float* out = a.out;
    bf16 *W13 = (bf16*)(ws + WS_W13), *W2T = (bf16*)(ws + WS_W2), *WinT = (bf16*)(ws + WS_WIN), *WoutT = (bf16*)(ws + WS_WOUT);
    float *Wg = (float*)(ws + WS_WG), *Gt = (float*)(ws + WS_G), *XF = (float*)(ws + WS_XF);
    bf16 *XB = (bf16*)(ws + WS_XB), *Zb = (bf16*)(ws + WS_ZH), *Hb = (bf16*)(ws + WS_ZH), *Yb = (bf16*)(ws + WS_Y), *ABb = (bf16*)(ws + WS_AB);
    float* DEC = (float*)(ws + WS_DEC); bf16* PSb = (bf16*)(ws + WS_PS);
    LAS float* scr = (LAS float*)(lds + wave * 16384);
    const int lo = a.ph_lo, hi = a.ph_hi;
#ifdef PHMASK
#define IN(k) (((PHMASK >> (k)) & 1) && lo <= (k) && (k) < hi)
#else
#define IN(k) (lo <= (k) && (k) < hi)
#endif
    unsigned* bar_ctr = (unsigned*)(ws + 32768);
    unsigned* pan_cnt = (unsigned*)(ws + 4096);
    if (bx == 0) { for (int i = tid; i < GB_WORDS / 64 + 1; i += 512) __hip_atomic_store(bar_ctr + 64 * i, 0u, __ATOMIC_RELAXED, __HIP_MEMORY_SCOPE_AGENT);
                   if (tid < 96) __hip_atomic_store(pan_cnt + 64 * tid, 0u, __ATOMIC_RELAXED, __HIP_MEMORY_SCOPE_AGENT); }
    unsigned bar_n = 0;
    volatile LAS unsigned* cen = (volatile LAS unsigned*)(lds + LDS_BYTES - 16);
#define CENSUS() do { if (tid == 0) { const unsigned x_ = gb_xcc(); __hip_atomic_fetch_add(bar_ctr + GB_CENSUS(x_), 1u, __ATOMIC_RELAXED, __HIP_MEMORY_SCOPE_AGENT); \
        unsigned sum_, mine_, nx_; do { sum_ = 0u; mine_ = 0u; nx_ = 0u; _Pragma("unroll") for (unsigned j_ = 0; j_ < 16; ++j_) { const unsigned c_ = gb_ld(bar_ctr + GB_CENSUS(j_)); sum_ += c_; nx_ += (c_ != 0u); mine_ = (j_ == x_) ? c_ : mine_; } \
            if (sum_ != (unsigned)G_) __builtin_amdgcn_s_sleep(1); } while (sum_ != (unsigned)G_); \
        cen[0] = mine_; cen[1] = nx_; } __syncthreads(); } while (0)
#define SEAM(k) do { if (IN(k) && IN((k) + 1)) { if ((k) == 0) { grid.sync(); CENSUS(); } else { ++bar_n; grid_bar(bar_ctr, bar_n, cen); } } } while (0)

    if (IN(0)) {
        convert_ffn(f1w1, f1w3, f1w2, W13, W2T, scr, gw, NGW, lane);
        for (int row = gw; row < M; row += NGW) {
#pragma unroll
            for (int j = 0; j < 8; ++j) { const f32x4 v = __builtin_nontemporal_load((const f32x4*)(x + (size_t)row * D + 4 * lane + 256 * j)); u32x2 w; w.x = pk(v.x, v.y); w.y = pk(v.z, v.w);
                *(u32x2*)(XB + (size_t)row * D + 4 * lane + 256 * j) = w; }
        }
        __syncthreads();
    }
    SEAM(0);
    if (IN(1)) { pg8::Gemm g{XB, W13, M, 2 * FF, D}; pg8::StaticOrder S; S.init(M, 2 * FF, G_, bx); pg8::EpiSwiglu E{Hb, FF};
        for (int rep = 0; rep < REP_GEMM; ++rep) pg8::gemm_phase<pg8::EpiSwiglu, pg8::StaticOrder, true, true>(lds, g, S, E);
        if (G_ != 256 || bx >= 128) { const int dgw = (G_ == 256) ? (bx - 128) * 8 + wave : gw, dngw = (G_ == 256) ? 128 * 8 : NGW;
        constexpr int IIN = (D / 64) * (ZC / 32), IOUT = (D / 64) * (D / 32);
        for (int it = dgw; it < IIN + IOUT; it += dngw) {
            if (it < IIN) { const int kb = it / (ZC / 32), nb = it % (ZC / 32); transpose_item(w_in, D, INC, WinT, scr, 64 * kb, 32 * nb, 32 * nb, lane); }
            else { const int r = it - IIN, kb = r / (D / 32), nb = r % (D / 32); transpose_item(w_out, D, D, WoutT, scr, 64 * kb, 32 * nb, 32 * nb, lane); }
        }
        for (int i = dgw * 64 + lane; i < 16 * D; i += dngw * 64) { const int k = i >> 4, j = i & 15; Wg[j * D + k] = w_in[(size_t)k * INC + ZC + j]; }
        }
        __syncthreads(); }
    SEAM(1);
    if (IN(2)) { pg8::Gemm g{Hb, W2T, M, D, FF}; pg8::StaticOrder S; S.init(M, D, G_, bx);
        if (G_ == 256) { pg8::EpiResLN E{XB, x, ALPHA, 0.5f, ln1g, ln1b, nullptr, XB, (float*)(ws + WS_X3), pan_cnt + 64 * 64};
            pg8::gemm_phase<pg8::EpiResLN, pg8::StaticOrder, false, true>(lds, g, S, E); }
        else { pg8::EpiRes E{x, out, D, ALPHA, 0.5f}; pg8::gemm_phase<pg8::EpiRes, pg8::StaticOrder, true, true>(lds, g, S, E); } }
    if (G_ != 256) { SEAM(2);
    if (IN(3)) { ln_phase<true, false>(out, ln1g, ln1b, XF, XB, Wg, Gt, gw, NGW, lane); } }
    SEAM(3);
    if (IN(4)) { pg8::Gemm g{XB, WinT, M, ZC, D}; pg8::EpiPlain E{Zb, ZC};
        if (G_ == 256) { pg8::MapOrder S; S.init(M, 32, G_, bx, 8, 0, 4); pg8::gemm_phase<pg8::EpiPlain, pg8::MapOrder, true, true>(lds, g, S, E); }
        else { pg8::StaticOrder S; S.init(M, ZC, G_, bx); pg8::gemm_phase<pg8::EpiPlain, pg8::StaticOrder, true, true>(lds, g, S, E); convert_ffn(f2w1, f2w3, f2w2, W13, W2T, scr, gw, NGW, lane); }
        __syncthreads(); }
    SEAM(4);
    bf16* OBp = (bf16*)out + (size_t)M * D;
    if (IN(5)) {
        for (int it = vcu; it < 1536; it += G_) { if (it < 1024) hgrn_pre(lds, Zb, hgrn_lb, ABb, DEC, it); else mlstm_pre(lds, Zb, XB, Wg, Gt, conv_w, conv_b, ig_b, fg_b, Yb, PSb, it - 1024); }
        ++bar_n; grid_bar(bar_ctr, bar_n, cen);
    }
    if (IN(5)) for (int rep = 0; rep < REP_SCAN; ++rep) {
        for (int it = vcu; it < 256; it += G_) {
            if (it < 128) hgrn_scan(lds, Zb, ABb, DEC, out, OBp, it);
            else mlstm_scan(lds, Zb, Gt, conv_w, conv_b, ig_b, fg_b, out, OBp, Yb, PSb, it - 128);
        }
    }
    if (IN(5) && G_ == 256 && vcu < 128) { __syncthreads();
        pg8::Gemm g{XB, WinT, M, ZC, D}; pg8::EpiPlain E{Zb, ZC}; pg8::MapOrder S; S.init(M, 4, 128, vcu, 4, 8, 8);
        pg8::gemm_phase<pg8::EpiPlain, pg8::MapOrder, true, true>(lds, g, S, E); __syncthreads();
        convert_ffn(f2w1, f2w3, f2w2, W13, W2T, scr, vcu * 8 + wave, 128 * 8, lane, 1); }
    SEAM(5);
    if (IN(6)) finalize_phase((const bf16*)out, OBp, Zb, hgrn_g, ml_g, Yb, gw, NGW, lane);
    SEAM(6);
    if (IN(7)) { pg8::Gemm g{Yb, WoutT, M, D, D}; pg8::StaticOrder S; S.init(M, D, G_, bx);
        if (G_ == 256) { pg8::EpiResLN E{XB, nullptr, ALPHA, 1.0f, ln2g, ln2b, nullptr, XB, (float*)(ws + WS_G + 512 * 1024), pan_cnt};
            pg8::gemm_phase<pg8::EpiResLN, pg8::StaticOrder, false, true>(lds, g, S, E); }
        else { pg8::EpiRes E{XF, out, D, ALPHA, 1.0f}; pg8::gemm_phase<pg8::EpiRes, pg8::StaticOrder, true, true>(lds, g, S, E); } }
    if (G_ != 256) { SEAM(7);
    if (IN(8)) ln_phase<false, false>(out, ln2g, ln2b, XF, XB, nullptr, nullptr, gw, NGW, lane); }
    SEAM(8);
    if (IN(9)) { pg8::Gemm g{XB, W13, M, 2 * FF, D}; pg8::StaticOrder S; S.init(M, 2 * FF, G_, bx); pg8::EpiSwiglu E{Hb, FF};
        pg8::gemm_phase<pg8::EpiSwiglu, pg8::StaticOrder, true, true>(lds, g, S, E);
        if (G_ == 256 && bx >= 128) convert_ffn(f2w1, f2w3, f2w2, W13, W2T, scr, (bx - 128) * 8 + wave, 128 * 8, lane, 2);
        __syncthreads(); }
    SEAM(9);
    if (IN(10)) { pg8::Gemm g{Hb, W2T, M, D, FF}; pg8::StaticOrder S; S.init(M, D, G_, bx);
        if (G_ == 256) { pg8::EpiResLN E{XB, nullptr, ALPHA, 0.5f, ln3g, ln3b, out, nullptr, (float*)(ws + WS_WG + 512 * 1024), pan_cnt + 64 * 32};
            pg8::gemm_phase<pg8::EpiResLN, pg8::StaticOrder, false, true>(lds, g, S, E); }
        else { pg8::EpiRes E{XF, out, D, ALPHA, 0.5f}; pg8::gemm_phase<pg8::EpiRes, pg8::StaticOrder, true, true>(lds, g, S, E); } }
    if (G_ != 256) { SEAM(10);
    if (IN(11)) ln_phase<false, false>(out, ln3g, ln3b, out, nullptr, nullptr, nullptr, gw, NGW, lane); }
#undef IN
#undef SEAM
}

#ifndef MK_N_LAUNCHES
#define MK_N_LAUNCHES 1
#endif
extern "C" void kernel_launch(void* const* d_in, const int* in_sizes, int n_in, void* d_out, int out_size, void* d_ws, size_t ws_size, hipStream_t stream) {
    static int grid = 0;
    if (grid == 0) {
        if (n_in != 22 || in_sizes[0] != M * D || out_size != M * D || ws_size < WS_END) { fprintf(stderr, "kernel_launch: unexpected shapes / workspace (n_in %d, ws %zu, need %zu)\n", n_in, ws_size, (size_t)WS_END); grid = -1; return; }
        int dev = 0, cus = 0, per_cu = 0;
        hipGetDevice(&dev); hipDeviceGetAttribute(&cus, hipDeviceAttributeMultiprocessorCount, dev);
        if (hipFuncSetAttribute((const void*)mk_fwd, hipFuncAttributeMaxDynamicSharedMemorySize, LDS_BYTES) != hipSuccess) { fprintf(stderr, "kernel_launch: hipFuncSetAttribute failed\n"); grid = -1; return; }
        if (hipOccupancyMaxActiveBlocksPerMultiprocessor(&per_cu, (const void*)mk_fwd, 512, LDS_BYTES) != hipSuccess || per_cu < 1) { fprintf(stderr, "kernel_launch: occupancy query failed (%d)\n", per_cu); (void)hipGetLastError(); per_cu = 1; }
        grid = cus * (per_cu > 1 ? 1 : per_cu);
        fprintf(stderr, "kernel_launch: grid %d (cus %d, per_cu %d), ws %zu\n", grid, cus, per_cu, ws_size);
    }
    if (grid < 0) return;
    Args a{};
    for (int i = 0; i < 22; ++i) a.in[i] = (const float*)d_in[i];
    a.out = (float*)d_out; a.ws = (unsigned char*)d_ws;
    for (int li = 0; li < MK_N_LAUNCHES; ++li) {
        a.ph_lo = (MK_N_LAUNCHES == 1) ? 0 : li; a.ph_hi = (MK_N_LAUNCHES == 1) ? NPH : li + 1;
        void* args[] = {&a};
        hipError_t e = hipLaunchCooperativeKernel((const void*)mk_fwd, dim3(grid), dim3(512), args, LDS_BYTES, stream);
        if (e != hipSuccess) { fprintf(stderr, "kernel_launch: cooperative launch failed: %s (grid %d)\n", hipGetErrorString(e), grid); break; }
    }
}
```
